# Optimizing an MI355X kernel written in HIP

```python
import jax, jax.numpy as jnp
from jax import lax
import numpy as np

D_MODEL = 1024
BATCH = 2
SEQ = 8192
DEPTH = 4

CHUNK = 64
EPS = 1e-5
CONV_WIDTH = D_MODEL
CONV_GROUPS = 16
SHORT_K = 3
SSD_HEAD_DIM = 64
SSD_HEADS = D_MODEL // SSD_HEAD_DIM
SSD_INNER = SSD_HEADS * SSD_HEAD_DIM
SSD_GROUPS = 2
SSD_STATE = 128
SSD_CONV_K = 4
SSD_CONV_DIM = SSD_INNER + 2 * SSD_GROUPS * SSD_STATE
MIX_WIDTH = CONV_WIDTH + SSD_INNER
D_FF = 4 * D_MODEL
IN_COLS = 3 * CONV_WIDTH + SSD_INNER + SSD_CONV_DIM + SSD_HEADS

kernel_name = "hybrid_shortconv_ssd_trunk"


def rmsnorm(x, w):
    xf = x.astype(jnp.float32)
    y = xf * lax.rsqrt(jnp.mean(xf * xf, axis=-1, keepdims=True) + EPS)
    return (y * w.astype(jnp.float32)).astype(x.dtype)


def causal_dwconv(u, w, b=None):
    k, c = w.shape
    y = lax.conv_general_dilated(
        u, w[:, None, :], window_strides=(1,), padding=[(k - 1, 0)],
        dimension_numbers=("NWC", "WIO", "NWC"), feature_group_count=c)
    if b is not None:
        y = y + b
    return y


def short_conv_mixer(u_b, u_c, u_h, conv_w):
    return u_b * causal_dwconv(u_c * u_h, conv_w)


def ssd_scan(xs, dt, a_head, bm, cm):
    f32 = jnp.float32
    b, t, h, p = xs.shape
    g, n = bm.shape[2], bm.shape[3]
    r = h // g
    nc = t // CHUNK
    x_c = (xs.astype(f32) * dt[..., None]).reshape(b, nc, CHUNK, g, r, p)
    a_c = (dt * a_head).reshape(b, nc, CHUNK, g, r)
    b_c = bm.astype(f32).reshape(b, nc, CHUNK, g, n)
    c_c = cm.astype(f32).reshape(b, nc, CHUNK, g, n)
    a_cum = jnp.cumsum(a_c, axis=2)
    causal = jnp.tril(jnp.ones((CHUNK, CHUNK), dtype=bool))
    seg = a_cum[:, :, :, None] - a_cum[:, :, None, :]
    decay = jnp.exp(jnp.where(causal[None, None, :, :, None, None], seg, -jnp.inf))
    scores = jnp.einsum("bclgn,bcsgn->bclsg", c_c, b_c)
    y_diag = jnp.einsum("bclsgr,bcsgrp->bclgrp", scores[..., None] * decay, x_c)
    decay_end = jnp.exp(a_cum[:, :, -1:] - a_cum)
    states = jnp.einsum("bclgn,bclgrp->bcgrpn", b_c, x_c * decay_end[..., None])
    chunk_decay = jnp.exp(a_cum[:, :, -1])

    def step(hs, inp):
        s_c, d_c = inp
        return hs * d_c[..., None, None] + s_c, hs

    h0 = jnp.zeros((b, g, r, p, n), dtype=f32)
    _, prev = lax.scan(step, h0, (jnp.moveaxis(states, 1, 0), jnp.moveaxis(chunk_decay, 1, 0)))
    prev = jnp.moveaxis(prev, 0, 1)
    y_off = jnp.einsum("bclgn,bcgrpn->bclgrp", c_c, prev) * jnp.exp(a_cum)[..., None]
    return (y_diag + y_off).reshape(b, t, h, p)


def ssd_mixer(z, xbc, dt_raw, conv_w, conv_b, dt_bias, a_log, d_skip, norm_w):
    b, t, _ = z.shape
    xbc = jax.nn.silu(causal_dwconv(xbc, conv_w, conv_b))
    xs, bm, cm = jnp.split(xbc, [SSD_INNER, SSD_INNER + SSD_GROUPS * SSD_STATE], axis=-1)
    xs = xs.reshape(b, t, SSD_HEADS, SSD_HEAD_DIM)
    bm = bm.reshape(b, t, SSD_GROUPS, SSD_STATE)
    cm = cm.reshape(b, t, SSD_GROUPS, SSD_STATE)
    dt = jax.nn.softplus(dt_raw.astype(jnp.float32) + dt_bias.astype(jnp.float32))
    a_head = -jnp.exp(a_log.astype(jnp.float32))
    y = ssd_scan(xs, dt, a_head, bm, cm)
    y = y + d_skip.astype(jnp.float32)[:, None] * xs.astype(jnp.float32)
    y = y.reshape(b, t, SSD_INNER).astype(z.dtype)
    gated = (y * jax.nn.silu(z)).reshape(b, t, SSD_GROUPS, SSD_INNER // SSD_GROUPS)
    gated = rmsnorm(gated, norm_w.reshape(SSD_GROUPS, SSD_INNER // SSD_GROUPS))
    return gated.reshape(b, t, SSD_INNER)


SPLITS = list(np.cumsum([CONV_WIDTH, CONV_WIDTH, CONV_WIDTH, SSD_INNER, SSD_CONV_DIM]))


def hybrid_layer(x, norm_mix_w, w_in, short_conv_w, ssd_conv_w, ssd_conv_b, dt_bias,
                 a_log, d_skip, ssd_norm_w, w_out, norm_mlp_w, w_up, w_down):
    h = rmsnorm(x, norm_mix_w)
    proj = jnp.einsum("btd,dc->btc", h, w_in)
    u_b, u_c, u_h, z, xbc, dt_raw = jnp.split(proj, SPLITS, axis=-1)
    y_a = short_conv_mixer(u_b, u_c, u_h, short_conv_w)
    y_b = ssd_mixer(z, xbc, dt_raw, ssd_conv_w, ssd_conv_b, dt_bias, a_log, d_skip, ssd_norm_w)
    y = jnp.concatenate([y_a, y_b], axis=-1)
    x = x + jnp.einsum("btc,cd->btd", y, w_out)
    h = rmsnorm(x, norm_mlp_w)
    hid = jnp.square(jax.nn.relu(jnp.einsum("btd,df->btf", h, w_up)))
    return x + jnp.einsum("btf,fd->btd", hid, w_down)


def setup_inputs(seed: int = 0) -> dict:
    key = jax.random.key(seed)
    ks = jax.random.split(key, 16)
    f32 = jnp.float32
    nrm = lambda k, shape, s: jax.random.normal(k, shape, f32) * s
    gain = lambda k, shape: 1.0 + 0.02 * jax.random.normal(k, shape, f32)
    dt0 = jnp.exp(jax.random.uniform(ks[6], (DEPTH, SSD_HEADS), f32, math_log(1e-3), math_log(1e-1)))
    dt_bias = dt0 + jnp.log(-jnp.expm1(-dt0))
    return {
        "x": jax.random.normal(ks[0], (BATCH, SEQ, D_MODEL), f32),
        "norm_mix_w": gain(ks[1], (DEPTH, D_MODEL)),
        "w_in": nrm(ks[2], (DEPTH, D_MODEL, IN_COLS), D_MODEL ** -0.5),
        "short_conv_w": nrm(ks[3], (DEPTH, SHORT_K, CONV_WIDTH), SHORT_K ** -0.5),
        "ssd_conv_w": nrm(ks[4], (DEPTH, SSD_CONV_K, SSD_CONV_DIM), SSD_CONV_K ** -0.5),
        "ssd_conv_b": nrm(ks[5], (DEPTH, SSD_CONV_DIM), 0.02),
        "dt_bias": dt_bias,
        "a_log": jnp.log(jax.random.uniform(ks[7], (DEPTH, SSD_HEADS), f32, 1.0, 16.0)),
        "d_skip": gain(ks[8], (DEPTH, SSD_HEADS)),
        "ssd_norm_w": gain(ks[9], (DEPTH, SSD_INNER)),
        "w_out": nrm(ks[10], (DEPTH, MIX_WIDTH, D_MODEL), MIX_WIDTH ** -0.5),
        "norm_mlp_w": gain(ks[11], (DEPTH, D_MODEL)),
        "w_up": nrm(ks[12], (DEPTH, D_MODEL, D_FF), D_MODEL ** -0.5),
        "w_down": nrm(ks[13], (DEPTH, D_FF, D_MODEL), D_FF ** -0.5),
        "final_norm_w": gain(ks[14], (D_MODEL,)),
    }


def math_log(v):
    return float(np.log(v))


def reference(x, norm_mix_w, w_in, short_conv_w, ssd_conv_w, ssd_conv_b, dt_bias, a_log,
              d_skip, ssd_norm_w, w_out, norm_mlp_w, w_up, w_down, final_norm_w):
    for i in range(DEPTH):
        x = hybrid_layer(x, norm_mix_w[i], w_in[i], short_conv_w[i], ssd_conv_w[i],
                         ssd_conv_b[i], dt_bias[i], a_log[i], d_skip[i], ssd_norm_w[i],
                         w_out[i], norm_mlp_w[i], w_up[i], w_down[i])
    return rmsnorm(x, final_norm_w)
```

```cpp
#include <hip/hip_runtime.h>
#include <hip/hip_cooperative_groups.h>
#include <cstdio>
#include <cstdint>
namespace cg = cooperative_groups;

#define LAS __attribute__((address_space(3)))
typedef unsigned short bf16_t;
typedef _Float16 bf16x8 __attribute__((ext_vector_type(8)));
typedef _Float16 h16x2 __attribute__((ext_vector_type(2)));
typedef float f32x4 __attribute__((ext_vector_type(4)));
typedef float f32x2 __attribute__((ext_vector_type(2)));
typedef unsigned u32x4 __attribute__((ext_vector_type(4)));
typedef unsigned u32x2 __attribute__((ext_vector_type(2)));

constexpr int DM = 1024, NB = 2, SEQ = 8192, DEPTH = 4, M = NB * SEQ;
constexpr int NCH = SEQ / 64;
constexpr int INC = 5648, INP = 5888;
constexpr int PW = 4608;
constexpr int C_XBC = 3072;
constexpr int FF = 4096, MIXW = 2048;
constexpr float EPS = 1e-5f;

constexpr size_t MiB = 1u << 20;
constexpr size_t WS_WB = 0, WB_BYTES = 32 * MiB;
constexpr size_t WB_IN = 0, WB_OUT = 12 * MiB, WB_UP = 16 * MiB, WB_DN = 24 * MiB;
constexpr size_t WS_PROJ = 64 * MiB;
constexpr size_t WS_XB = 240 * MiB;
constexpr size_t WS_ST = 272 * MiB;
constexpr size_t WS_DT = 336 * MiB;
constexpr size_t WS_SSQ = 337 * MiB;
constexpr size_t WS_CD = 338 * MiB;
constexpr size_t WS_BAR = 338 * MiB + 65536;
constexpr size_t BAR_BYTES = 32768;
constexpr size_t WS_END = 339 * MiB;

constexpr int LDS_BYTES = 147456 + 256;
constexpr int L_SSQ = 131072, L_MISC = 147456;

__device__ __forceinline__ unsigned cvt_pk_bf16(float lo, float hi) { h16x2 v; v.x = (_Float16)__builtin_amdgcn_fmed3f(lo, -65504.f, 65504.f); v.y = (_Float16)__builtin_amdgcn_fmed3f(hi, -65504.f, 65504.f); return __builtin_bit_cast(unsigned, v); }
__device__ __forceinline__ float bf_lo(unsigned w) { return (float)__builtin_bit_cast(h16x2, w).x; }
__device__ __forceinline__ float bf_hi(unsigned w) { return (float)__builtin_bit_cast(h16x2, w).y; }
__device__ __forceinline__ float bf2f(bf16_t h) { return (float)__builtin_bit_cast(_Float16, h); }
__device__ __forceinline__ void unpack8(const u32x4 r, float (&o)[8]) { o[0] = bf_lo(r.x); o[1] = bf_hi(r.x); o[2] = bf_lo(r.y); o[3] = bf_hi(r.y); o[4] = bf_lo(r.z); o[5] = bf_hi(r.z); o[6] = bf_lo(r.w); o[7] = bf_hi(r.w); }
__device__ __forceinline__ u32x4 pack8(const float (&o)[8]) { u32x4 w; w.x = cvt_pk_bf16(o[0], o[1]); w.y = cvt_pk_bf16(o[2], o[3]); w.z = cvt_pk_bf16(o[4], o[5]); w.w = cvt_pk_bf16(o[6], o[7]); return w; }
__device__ __forceinline__ int lane_id() { int l; asm volatile("v_mbcnt_lo_u32_b32 %0, -1, 0\n\tv_mbcnt_hi_u32_b32 %0, -1, %0" : "=v"(l)); return l; }
__device__ __forceinline__ float silu_f(float x) { return x * __builtin_amdgcn_rcpf(1.f + __expf(-x)); }

__device__ __forceinline__ float row_rstd(const float* ssqp, int row) {
    const f32x4* p = (const f32x4*)(ssqp + (size_t)row * 16);
    const f32x4 a = p[0], b = p[1], c = p[2], d = p[3];
    const float s = (((a.x + a.y) + (a.z + a.w)) + ((b.x + b.y) + (b.z + b.w))) + (((c.x + c.y) + (c.z + c.w)) + ((d.x + d.y) + (d.z + d.w)));
    return rsqrtf(s * (1.f / 1024.f) + EPS);
}

__device__ __forceinline__ float row_rstd_lds(LAS unsigned char* lds, int rl) {
    const LAS f32x4* p = (const LAS f32x4*)(lds + 131072 + rl * 64);
    const f32x4 a = p[0], b = p[1], c = p[2], d = p[3];
    const float s = (((a.x + a.y) + (a.z + a.w)) + ((b.x + b.y) + (b.z + b.w))) + (((c.x + c.y) + (c.z + c.w)) + ((d.x + d.y) + (d.z + d.w)));
    return rsqrtf(s * (1.f / 1024.f) + EPS);
}

namespace pg8 {
constexpr int BM = 256, BK = 64, HALF = 128, HTB = HALF * BK * 2, STAGE_BYTES = 8 * HTB, NXCD = 8, WGM = 8;
__host__ __device__ __forceinline__ int lds_byte(int r, int c) { const int st = (r >> 4) * 2 + (c >> 5), rr = r & 15, cc = c & 31, ob = rr * 64 + cc * 2; return st * 1024 + (ob ^ (((ob >> 9) & 1) << 5)); }
__host__ __device__ __forceinline__ void stage_rc(int b, int& R, int& C) { const int st = b / 1024, sb = b % 1024, swz = sb ^ (((sb >> 9) & 1) << 5); R = (st >> 1) * 16 + swz / 64; C = (st & 1) * 32 + (swz % 64) / 2; }
__host__ __device__ __forceinline__ int perm32(int rho) { const int n = rho >> 4, i = rho & 15; return 8 * (i >> 2) + 4 * n + (i & 3); }
struct Unit { int pm, pn; };
struct Gemm { const bf16_t* A; const bf16_t* Bt; int M, N, K, lda; };
struct StaticOrder {
    int nM, nN, nwg, G, c;
    __host__ __device__ void init(int M_, int N_, int G_, int c_) { nM = M_ / BM; nN = N_ / BM; nwg = nM * nN; G = G_; c = c_; }
    __host__ __device__ bool next(int i, Unit& u) const {
        const long L = (long)i * G + c; if (L >= nwg) return false;
        int wgid = (int)L; { const int q = nwg / NXCD, r = nwg % NXCD, xcd = wgid % NXCD, off = wgid / NXCD; wgid = (xcd < r ? xcd * (q + 1) : r * (q + 1) + (xcd - r) * q) + off; }
        const int nig = WGM * nN, gid = wgid / nig, fm = gid * WGM, gsz = (nM - fm) < WGM ? (nM - fm) : WGM;
        u.pm = fm + ((wgid % nig) % gsz); u.pn = (wgid % nig) / gsz; return true;
    }
};
template <class Epi, bool ALIGN_EPI>
__device__ __forceinline__ void gemm_phase(LAS unsigned char* lds, const Gemm g, const StaticOrder& S, const Epi& E, const int wave_) {
    int lane_ = lane_id(); asm volatile("" : "+v"(lane_));
    int wv_ = wave_; asm volatile("" : "+s"(wv_));
    const int wid = wv_, lane = lane_, tid = wid * 64 + lane, wr = wid >> 2, wc = wid & 3, fr = lane & 15, fq = lane >> 4;
    const int K = g.K, nt = K / BK, lda = g.lda;
    unsigned voffA[2], voffB[2];
#pragma unroll
    for (int i = 0; i < 2; ++i) { int R, C; stage_rc(tid * 16 + i * 8192, R, C); const int Rb = (R & ~31) + perm32(R & 31);
        voffA[i] = (unsigned)(R * lda + C) * 2u; voffB[i] = (unsigned)(Rb * K + C) * 2u; }
    const size_t kstep = (size_t)(BK * 2);
    const size_t hstepA = (size_t)HALF * lda * 2, hstepB = (size_t)HALF * K * 2;
    const size_t tstepA = 2 * hstepA, tstepB = 2 * hstepB;
    const unsigned ldsw = (unsigned)wid * 1024u;
    const int aoff = lds_byte(wr * 64 + fr, fq * 8), boff = lds_byte(wc * 32 + fr, fq * 8);
#define PG8_SA(b, h) (((b) * 2 + (h)) * HTB)
#define PG8_SB(b, h) ((4 + (b) * 2 + (h)) * HTB)
#define PG8_STAGE(bufoff, gbase, voff) do { _Pragma("unroll") for (int _i = 0; _i < 2; ++_i) \
        __builtin_amdgcn_global_load_lds((const unsigned*)((const char*)(gbase) + (voff)[_i]), (LAS unsigned*)(lds + (bufoff) + ldsw + _i * 8192), 16, 0, 0); } while (0)
#define PG8_LDA(dst, b, h) do { _Pragma("unroll") for (int m = 0; m < 4; ++m) _Pragma("unroll") for (int k = 0; k < 2; ++k) dst[m][k] = *(const LAS bf16x8*)(lds + PG8_SA(b, h) + aoff + m * 2048 + k * 1024); } while (0)
#define PG8_LDB(dst, b, h) do { _Pragma("unroll") for (int n = 0; n < 2; ++n) _Pragma("unroll") for (int k = 0; k < 2; ++k) dst[n][k] = *(const LAS bf16x8*)(lds + PG8_SB(b, h) + boff + n * 2048 + k * 1024); } while (0)
#define PG8_MMA(ai, bj, At, Bt) do { __builtin_amdgcn_s_setprio(1); _Pragma("unroll") for (int m = 0; m < 4; ++m) _Pragma("unroll") for (int n = 0; n < 2; ++n) _Pragma("unroll") for (int k = 0; k < 2; ++k) \
        acc[ai][bj][m][n] = __builtin_amdgcn_mfma_f32_16x16x32_f16(Bt[n][k], At[m][k], acc[ai][bj][m][n], 0, 0, 0); __builtin_amdgcn_s_setprio(0); } while (0)
#define PG8_WAIT_V(n) asm volatile("s_waitcnt vmcnt(" #n ")" ::: "memory")
#define PG8_WAIT_L(n) asm volatile("s_waitcnt lgkmcnt(" #n ")" ::: "memory")
#define PG8_BAR __builtin_amdgcn_s_barrier()
#define PG8_SCHED __builtin_amdgcn_sched_barrier(0)
#define PG8_SSQ_HOOK(U) do { const unsigned hook_lo = (unsigned)lane_id() * 16u; _Pragma("unroll") for (int _i = 0; _i < 2; ++_i) \
        __builtin_amdgcn_global_load_lds((const unsigned*)((const char*)E.ssqp + (size_t)((U).pm * BM + 32 * wid + 16 * _i) * 64 + hook_lo), (LAS unsigned*)(lds + L_SSQ + (32 * wid + 16 * _i) * 64), 16, 0, 0); } while (0)
    Unit cur, nxt; int ui = 0;
    if (!S.next(0, cur)) return;
    if constexpr (Epi::PREFETCH_SSQ) PG8_SSQ_HOOK(cur);
    f32x4 acc[2][2][4][2];
#pragma unroll
    for (int a = 0; a < 2; ++a)
#pragma unroll
        for (int b = 0; b < 2; ++b)
#pragma unroll
            for (int m = 0; m < 4; ++m)
#pragma unroll
                for (int n = 0; n < 2; ++n) acc[a][b][m][n] = (f32x4){0.f, 0.f, 0.f, 0.f};
    bf16x8 At[4][2], B0[2][2], B1[2][2];
    const char* cA = (const char*)g.A + (size_t)cur.pm * tstepA; const char* cB = (const char*)g.Bt + (size_t)cur.pn * tstepB;
    PG8_STAGE(PG8_SB(0, 0), cB, voffB); PG8_STAGE(PG8_SB(0, 1), cB + hstepB, voffB); PG8_STAGE(PG8_SA(0, 0), cA, voffA); PG8_STAGE(PG8_SA(0, 1), cA + hstepA, voffA);
    if (wr == 1) PG8_BAR;
    PG8_WAIT_V(2); PG8_BAR;
    PG8_STAGE(PG8_SB(1, 0), cB + kstep, voffB); PG8_STAGE(PG8_SA(1, 0), cA + kstep, voffA); PG8_STAGE(PG8_SB(1, 1), cB + hstepB + kstep, voffB);
    PG8_WAIT_V(6); PG8_BAR;
    for (;;) {
        const bool has_next = S.next(ui + 1, nxt);
        const char* nA = has_next ? (const char*)g.A + (size_t)nxt.pm * tstepA : cA; const char* nB = has_next ? (const char*)g.Bt + (size_t)nxt.pn * tstepB : cB;
        for (int t = 0; t < nt; t += 2) {
            const bool last = (t == nt - 2);
            const char* a1 = cA + (size_t)(t + 1) * kstep;
            const char* a2 = last ? nA : cA + (size_t)(t + 2) * kstep; const char* b2 = last ? nB : cB + (size_t)(t + 2) * kstep;
            const char* a3 = a2 + kstep; const char* b3 = b2 + kstep;
            PG8_LDB(B0, 0, 0); PG8_LDB(B1, 0, 1); PG8_SCHED; PG8_LDA(At, 0, 0); PG8_STAGE(PG8_SA(1, 1), a1 + hstepA, voffA);
            PG8_WAIT_V(8); PG8_WAIT_L(0); PG8_BAR; PG8_MMA(0, 0, At, B0); PG8_MMA(0, 1, At, B1); PG8_BAR; PG8_SCHED;
            PG8_LDA(At, 0, 1); PG8_STAGE(PG8_SB(0, 0), b2, voffB); PG8_STAGE(PG8_SB(0, 1), b2 + hstepB, voffB); PG8_STAGE(PG8_SA(0, 0), a2, voffA);
            PG8_WAIT_V(8); PG8_WAIT_L(0); PG8_BAR; PG8_MMA(1, 0, At, B0); PG8_MMA(1, 1, At, B1); PG8_BAR; PG8_SCHED;
            PG8_LDB(B0, 1, 0); PG8_LDB(B1, 1, 1); PG8_SCHED; PG8_LDA(At, 1, 0); PG8_STAGE(PG8_SA(0, 1), a2 + hstepA, voffA);
            PG8_WAIT_V(8); PG8_WAIT_L(0); PG8_BAR; PG8_MMA(0, 0, At, B0); PG8_MMA(0, 1, At, B1); PG8_BAR; PG8_SCHED;
            PG8_LDA(At, 1, 1); PG8_STAGE(PG8_SB(1, 0), b3, voffB); PG8_STAGE(PG8_SB(1, 1), b3 + hstepB, voffB); PG8_STAGE(PG8_SA(1, 0), a3, voffA);
            PG8_WAIT_V(8); PG8_WAIT_L(0); PG8_BAR; PG8_MMA(1, 0, At, B0); PG8_MMA(1, 1, At, B1); PG8_BAR; PG8_SCHED;
        }
        if constexpr (ALIGN_EPI) { if (wr == 0) PG8_BAR; }
        { const int l2 = lane_id(); E(acc, cur, wr, wc, l2 & 15, l2 >> 4, lds); }
        if (!has_next) break;
#pragma unroll
        for (int a = 0; a < 2; ++a)
#pragma unroll
            for (int b = 0; b < 2; ++b)
#pragma unroll
                for (int m = 0; m < 4; ++m)
#pragma unroll
                    for (int n = 0; n < 2; ++n) acc[a][b][m][n] = (f32x4){0.f, 0.f, 0.f, 0.f};
        cur = nxt; cA = nA; cB = nB; ++ui;
        if constexpr (Epi::PREFETCH_SSQ) { PG8_BAR; PG8_SSQ_HOOK(cur); }
        if constexpr (ALIGN_EPI) { if (wr == 1) PG8_BAR; }
    }
    PG8_WAIT_V(0);
    if constexpr (!ALIGN_EPI) { if (wr == 0) PG8_BAR; }
    PG8_BAR;
#undef PG8_SSQ_HOOK
#undef PG8_SA
#undef PG8_SB
#undef PG8_STAGE
#undef PG8_LDA
#undef PG8_LDB
#undef PG8_MMA
#undef PG8_WAIT_V
#undef PG8_WAIT_L
#undef PG8_BAR
#undef PG8_SCHED
}
}

struct EpiInProj {
    static constexpr bool PREFETCH_SSQ = true;
    bf16_t* P; float* DT; const float* ssqp;
    __device__ __forceinline__ void operator()(f32x4 (&acc)[2][2][4][2], const pg8::Unit& u, int wr, int wc, int fr, int fq, LAS unsigned char* lds) const {
        const int pn = u.pn, row0 = u.pm * 256 + wr * 64 + fr, cw0 = wc * 32 + 8 * fq;
#pragma unroll
        for (int ai = 0; ai < 2; ++ai)
#pragma unroll
            for (int m = 0; m < 4; ++m) {
                const int row = row0 + ai * 128 + m * 16; const float rs = row_rstd_lds(lds, ai * 128 + wr * 64 + m * 16 + fr);
                if (pn >= 8 && pn < 16) {
                    const float r2 = rs * rs;
                    const f32x4 v0 = acc[ai][0][m][0] * acc[ai][1][m][0] * r2, v1 = acc[ai][0][m][1] * acc[ai][1][m][1] * r2;
                    u32x4 w; w.x = cvt_pk_bf16(v0[0], v0[1]); w.y = cvt_pk_bf16(v0[2], v0[3]); w.z = cvt_pk_bf16(v1[0], v1[1]); w.w = cvt_pk_bf16(v1[2], v1[3]);
                    *(u32x4*)(P + (size_t)row * PW + 2048 + 128 * (pn - 8) + cw0) = w;
                } else {
#pragma unroll
                    for (int bj = 0; bj < 2; ++bj) {
                        const int gcol = pn * 256 + bj * 128 + cw0; const f32x4 v0 = acc[ai][bj][m][0] * rs, v1 = acc[ai][bj][m][1] * rs;
                        if (pn < 22) { u32x4 w; w.x = cvt_pk_bf16(v0[0], v0[1]); w.y = cvt_pk_bf16(v0[2], v0[3]); w.z = cvt_pk_bf16(v1[0], v1[1]); w.w = cvt_pk_bf16(v1[2], v1[3]);
                            *(u32x4*)(P + (size_t)row * PW + (pn < 8 ? gcol : gcol - 1024)) = w; }
                        else if (gcol < INC) { float* d = DT + (size_t)row * 16 + (gcol - 5632); *(f32x4*)d = v0; *(f32x4*)(d + 4) = v1; }
                    }
                }
            }
    }
};
struct EpiResid {
    static constexpr bool PREFETCH_SSQ = false;
    bf16_t* XB; float* ssqp;
    __device__ __forceinline__ void operator()(f32x4 (&acc)[2][2][4][2], const pg8::Unit& u, int wr, int wc, int fr, int fq, LAS unsigned char* lds) const {
        const int row0 = u.pm * 256 + wr * 64 + fr, col0 = u.pn * 256 + wc * 32 + 8 * fq;
#pragma unroll
        for (int ai = 0; ai < 2; ++ai) {
            u32x4 bs[4][2];
#pragma unroll
            for (int m = 0; m < 4; ++m)
#pragma unroll
                for (int bj = 0; bj < 2; ++bj) bs[m][bj] = *(const u32x4*)(XB + (size_t)(row0 + ai * 128 + m * 16) * DM + col0 + bj * 128);
            asm volatile("" ::: "memory");
#pragma unroll
            for (int m = 0; m < 4; ++m) {
                const int row = row0 + ai * 128 + m * 16; float ss = 0.f;
#pragma unroll
                for (int bj = 0; bj < 2; ++bj) {
                    const size_t off = (size_t)row * DM + col0 + bj * 128;
                    float b[8]; unpack8(bs[m][bj], b);
                    const f32x4 v0 = acc[ai][bj][m][0] + (f32x4){b[0], b[1], b[2], b[3]}, v1 = acc[ai][bj][m][1] + (f32x4){b[4], b[5], b[6], b[7]};
                    u32x4 w; w.x = cvt_pk_bf16(v0[0], v0[1]); w.y = cvt_pk_bf16(v0[2], v0[3]); w.z = cvt_pk_bf16(v1[0], v1[1]); w.w = cvt_pk_bf16(v1[2], v1[3]);
                    *(u32x4*)(XB + off) = w;
                    ss += ((v0[0] * v0[0] + v0[1] * v0[1]) + (v0[2] * v0[2] + v0[3] * v0[3])) + ((v1[0] * v1[0] + v1[1] * v1[1]) + (v1[2] * v1[2] + v1[3] * v1[3]));
                }
                ss += __shfl_xor(ss, 16); ss += __shfl_xor(ss, 32);
                if (fq == 0) ssqp[(size_t)row * 16 + u.pn * 4 + wc] = ss;
            }
        }
    }
};
struct EpiFinal {
    static constexpr bool PREFETCH_SSQ = false;
    const bf16_t* XB; float* out; float* ssqp; unsigned* cnt; const float* fw;
    __device__ __forceinline__ void operator()(f32x4 (&acc)[2][2][4][2], const pg8::Unit& u, int wr, int wc, int fr, int fq, LAS unsigned char* lds) const {
        const int row0 = u.pm * 256 + wr * 64 + fr, col0 = u.pn * 256 + wc * 32 + 8 * fq;
#pragma unroll
        for (int ai = 0; ai < 2; ++ai) {
            u32x4 bs[4][2];
#pragma unroll
            for (int m = 0; m < 4; ++m)
#pragma unroll
                for (int bj = 0; bj < 2; ++bj) bs[m][bj] = *(const u32x4*)(XB + (size_t)(row0 + ai * 128 + m * 16) * DM + col0 + bj * 128);
            asm volatile("" ::: "memory");
#pragma unroll
            for (int m = 0; m < 4; ++m) {
                const int row = row0 + ai * 128 + m * 16; float ss = 0.f;
#pragma unroll
                for (int bj = 0; bj < 2; ++bj) {
                    float b[8]; unpack8(bs[m][bj], b);
                    const f32x4 v0 = acc[ai][bj][m][0] + (f32x4){b[0], b[1], b[2], b[3]}, v1 = acc[ai][bj][m][1] + (f32x4){b[4], b[5], b[6], b[7]};
                    acc[ai][bj][m][0] = v0; acc[ai][bj][m][1] = v1;
                    ss += ((v0[0] * v0[0] + v0[1] * v0[1]) + (v0[2] * v0[2] + v0[3] * v0[3])) + ((v1[0] * v1[0] + v1[1] * v1[1]) + (v1[2] * v1[2] + v1[3] * v1[3]));
                }
                ss += __shfl_xor(ss, 16); ss += __shfl_xor(ss, 32);
                if (fq == 0) __hip_atomic_store(ssqp + (size_t)row * 16 + u.pn * 4 + wc, ss, __ATOMIC_RELAXED, __HIP_MEMORY_SCOPE_AGENT);
            }
        }
        asm volatile("s_waitcnt vmcnt(0)" ::: "memory");
        unsigned* pc = cnt + 64 * u.pm;
        const int ln = lane_id();
        if (ln == 0) __hip_atomic_fetch_add(pc, 1u, __ATOMIC_RELAXED, __HIP_MEMORY_SCOPE_AGENT);
        if (wr == 0 && wc == 0) { unsigned sp = 0u;
          while ((unsigned)__builtin_amdgcn_readfirstlane((int)__hip_atomic_load(pc, __ATOMIC_RELAXED, __HIP_MEMORY_SCOPE_AGENT)) < 32u) { if (++sp > (1u << 20)) break; __builtin_amdgcn_s_sleep(2); } }
        __builtin_amdgcn_s_barrier();
        __builtin_amdgcn_fence(__ATOMIC_ACQUIRE, "agent");
        asm volatile("s_waitcnt vmcnt(0)" ::: "memory");
#pragma unroll
        for (int ai = 0; ai < 2; ++ai)
#pragma unroll
            for (int m = 0; m < 4; ++m) {
                const int row = row0 + ai * 128 + m * 16;
                const f32x4 p4 = *(const f32x4*)(ssqp + (size_t)row * 16 + 4 * fq);
                float tot = (p4.x + p4.y) + (p4.z + p4.w); tot += __shfl_xor(tot, 16); tot += __shfl_xor(tot, 32);
                const float rs = rsqrtf(tot * (1.f / 1024.f) + EPS);
#pragma unroll
                for (int bj = 0; bj < 2; ++bj) {
                    const size_t off = (size_t)row * DM + col0 + bj * 128;
                    const f32x4 w0 = *(const f32x4*)(fw + col0 + bj * 128), w1 = *(const f32x4*)(fw + col0 + bj * 128 + 4);
                    *(f32x4*)(out + off) = acc[ai][bj][m][0] * rs * w0; *(f32x4*)(out + off + 4) = acc[ai][bj][m][1] * rs * w1;
                }
            }
    }
};
struct EpiUp {
    static constexpr bool PREFETCH_SSQ = true;
    bf16_t* H; const float* ssqp;
    __device__ __forceinline__ void operator()(f32x4 (&acc)[2][2][4][2], const pg8::Unit& u, int wr, int wc, int fr, int fq, LAS unsigned char* lds) const {
        const int row0 = u.pm * 256 + wr * 64 + fr, col0 = u.pn * 256 + wc * 32 + 8 * fq;
#pragma unroll
        for (int ai = 0; ai < 2; ++ai)
#pragma unroll
            for (int m = 0; m < 4; ++m) {
                const int row = row0 + ai * 128 + m * 16; const float rs = row_rstd_lds(lds, ai * 128 + wr * 64 + m * 16 + fr);
#pragma unroll
                for (int bj = 0; bj < 2; ++bj) {
                    f32x4 v0 = acc[ai][bj][m][0] * rs, v1 = acc[ai][bj][m][1] * rs;
#pragma unroll
                    for (int e = 0; e < 4; ++e) { const float a = fmaxf(v0[e], 0.f), b = fmaxf(v1[e], 0.f); v0[e] = a * a; v1[e] = b * b; }
                    u32x4 w; w.x = cvt_pk_bf16(v0[0], v0[1]); w.y = cvt_pk_bf16(v0[2], v0[3]); w.z = cvt_pk_bf16(v1[0], v1[1]); w.w = cvt_pk_bf16(v1[2], v1[3]);
                    *(u32x4*)(H + (size_t)row * FF + col0 + bj * 128) = w;
                }
            }
    }
};


#define XB_TMO      128
#define XB_XCNT(j)  (256  + 64 * (j))
#define XB_XSUB(j)  (1280 + 64 * (j))
#define XB_XGEN(j)  (2304 + 64 * (j))
#define XB_TOP      3328
#define XB_TOPGEN   3392
#define XCD_BAR_WORDS 3456
#define XB_SPIN_CAP (1u << 18)
__device__ __forceinline__ unsigned xb_ld(unsigned* p)              { return __hip_atomic_load(p, __ATOMIC_RELAXED, __HIP_MEMORY_SCOPE_AGENT); }
__device__ __forceinline__ unsigned xb_add(unsigned* p, unsigned v) { return __hip_atomic_fetch_add(p, v, __ATOMIC_RELAXED, __HIP_MEMORY_SCOPE_AGENT); }
__device__ __forceinline__ unsigned xb_xcc_id() { return (unsigned)__builtin_amdgcn_s_getreg((3 << 11) | 20) & 0xFu; }
#define XB_SPIN(cond, bar) do { unsigned _sp = 0; while (cond) { __builtin_amdgcn_s_sleep(1); \
    if ((++_sp & 255u) == 0u) { if (xb_ld(&(bar)[XB_TMO])) break; if (_sp > XB_SPIN_CAP) { atomicAdd(&(bar)[XB_TMO], 1u); break; } } } } while (0)
struct XcdBarrier { unsigned* bar; unsigned x; volatile LAS unsigned* st; };
__device__ __forceinline__ XcdBarrier xcd_barrier_post(unsigned* bar, volatile LAS unsigned* st) {
    XcdBarrier b; b.bar = bar; b.x = xb_xcc_id(); b.st = st;
    if (threadIdx.x == 0) (void)xb_add(&bar[XB_XCNT(b.x)], 1u);
    return b;
}
__device__ __forceinline__ void xcd_barrier_complete(unsigned* bar, unsigned x, unsigned& nloc, unsigned& nx) {
    const unsigned G = gridDim.x * gridDim.y * gridDim.z;
    unsigned sum, cnt, mine, sp = 0u;
    for (;;) {
        sum = 0u; cnt = 0u; mine = 0u;
#pragma unroll
        for (unsigned j = 0; j < 16; ++j) { const unsigned c = xb_ld(&bar[XB_XCNT(j)]); sum += c; cnt += (c > 0u) ? 1u : 0u; mine = (j == x) ? c : mine; }
        if (sum == G) break;
        __builtin_amdgcn_s_sleep(1);
        if ((++sp & 255u) == 0u) { if (xb_ld(&bar[XB_TMO])) break; if (sp > XB_SPIN_CAP) { atomicAdd(&bar[XB_TMO], 1u); break; } }
    }
    nloc = mine > 0u ? mine : 1u; nx = cnt > 0u ? cnt : 1u;
}
__device__ __forceinline__ void xcd_barrier(const XcdBarrier& b) {
    asm volatile("s_waitcnt vmcnt(0)" ::: "memory");
    __syncthreads();
    if (threadIdx.x == 0) {
        unsigned* bar = b.bar;
        __builtin_amdgcn_s_waitcnt(0);
        unsigned nloc = b.st[0], nx = b.st[1];
        if (nloc == 0u) { xcd_barrier_complete(bar, b.x, nloc, nx); b.st[0] = nloc; b.st[1] = nx; }
        const unsigned old = xb_add(&bar[XB_XSUB(b.x)], 1u);
        const unsigned gen = old / nloc;
        if (old + 1u == (gen + 1u) * nloc) {
            __builtin_amdgcn_fence(__ATOMIC_RELEASE, "agent");
            asm volatile("s_waitcnt vmcnt(0)" ::: "memory");
            const unsigned og = xb_add(&bar[XB_TOP], 1u);
            const unsigned tg = og / nx;
            if (og + 1u == (tg + 1u) * nx) xb_add(&bar[XB_TOPGEN], 1u);
            else XB_SPIN(xb_ld(&bar[XB_TOPGEN]) == tg, bar);
            __builtin_amdgcn_fence(__ATOMIC_ACQUIRE, "agent");
            xb_add(&bar[XB_XGEN(b.x)], 1u);
            asm volatile("s_waitcnt vmcnt(0)" ::: "memory");
        } else {
            XB_SPIN(xb_ld(&bar[XB_XGEN(b.x)]) == gen, bar);
            __builtin_amdgcn_fence(__ATOMIC_ACQUIRE, "agent");
            asm volatile("s_waitcnt vmcnt(0)" ::: "memory");
        }
    }
    __syncthreads();
}

struct Args { const float* in[15]; float* out; unsigned char* ws; int ph_lo, ph_hi; };

__device__ __forceinline__ float wave_sum(float v) {
#pragma unroll
    for (int o = 1; o < 64; o <<= 1) v += __shfl_xor(v, o);
    return v;
}

template <bool PERMROW>
__device__ __forceinline__ void transpose_item(const float* W, int K, int N, int nblk, bf16_t* WT, const float* scale, LAS float* scr, int item, int lane) {
    const int kb = item / nblk, nb = item % nblk, k0 = 64 * kb, n0 = 32 * nb;
    const int n = n0 + (lane & 31);
    const float* wp = W + (size_t)(k0 + (lane >> 5)) * N + n;
    float v[32];
    if (n < N) {
#pragma unroll
        for (int i = 0; i < 32; ++i) v[i] = wp[(size_t)(2 * i) * N];
    } else {
#pragma unroll
        for (int i = 0; i < 32; ++i) v[i] = 0.f;
    }
    const int c = lane & 7;
    f32x4 s0 = (f32x4){1.f, 1.f, 1.f, 1.f}, s1 = s0;
    if (scale) { s0 = *(const f32x4*)(scale + k0 + 8 * c); s1 = *(const f32x4*)(scale + k0 + 8 * c + 4); }
    asm volatile("" ::: "memory");
#pragma unroll
    for (int i = 0; i < 32; ++i) scr[(2 * i + (lane >> 5)) * 33 + (lane & 31)] = v[i];
    asm volatile("s_waitcnt lgkmcnt(0)" ::: "memory");
#pragma unroll
    for (int j = 0; j < 4; ++j) { const int nn = (lane >> 3) + 8 * j; const LAS float* sp = scr + (8 * c) * 33 + nn;
        u32x4 o; o.x = cvt_pk_bf16(sp[0 * 33] * s0.x, sp[1 * 33] * s0.y); o.y = cvt_pk_bf16(sp[2 * 33] * s0.z, sp[3 * 33] * s0.w); o.z = cvt_pk_bf16(sp[4 * 33] * s1.x, sp[5 * 33] * s1.y); o.w = cvt_pk_bf16(sp[6 * 33] * s1.z, sp[7 * 33] * s1.w);
        int row = n0 + nn;
        if (PERMROW) {
            if (row >= 1024 && row < 3072) { const int hsel = (row >= 2048) ? 1 : 0, ch = row - 1024 - 1024 * hsel; row = 2048 + 256 * (ch >> 7) + 128 * hsel + (ch & 127); }
            else if (row >= 3072 && row < 4096) row -= 2048; }
        *(u32x4*)(WT + (size_t)row * K + k0 + 8 * c) = o; }
    asm volatile("s_waitcnt lgkmcnt(0)" ::: "memory");
}
__device__ __forceinline__ void convert_layer(const Args& a, int layer, unsigned char* wb, LAS float* scr, int wi, int nw, int lane, int it_lo = 0, int it_hi = 1 << 30) {
    constexpr int I_IN = 16 * 177, I_OUT = 32 * 32, I_UP = 16 * 128, I_DN = 64 * 32;
    const float* w_in = a.in[2] + (size_t)layer * DM * INC; const float* w_out = a.in[10] + (size_t)layer * MIXW * DM;
    const float* w_up = a.in[12] + (size_t)layer * DM * FF; const float* w_dn = a.in[13] + (size_t)layer * FF * DM;
    const int it_end = (it_hi < I_IN + I_OUT + I_UP + I_DN) ? it_hi : I_IN + I_OUT + I_UP + I_DN;
    for (int it = it_lo + wi; it < it_end; it += nw) {
        int r = it;
        if (r < I_IN) { transpose_item<true>(w_in, DM, INC, 177, (bf16_t*)(wb + WB_IN), a.in[1] + layer * DM, scr, r, lane); continue; } r -= I_IN;
        if (r < I_OUT) { transpose_item<false>(w_out, MIXW, DM, 32, (bf16_t*)(wb + WB_OUT), nullptr, scr, r, lane); continue; } r -= I_OUT;
        if (r < I_UP) { transpose_item<false>(w_up, DM, FF, 128, (bf16_t*)(wb + WB_UP), a.in[11] + layer * DM, scr, r, lane); continue; } r -= I_UP;
        transpose_item<false>(w_dn, FF, DM, 32, (bf16_t*)(wb + WB_DN), nullptr, scr, r, lane);
    }
}

constexpr int CONV_SPLIT = 4608;
constexpr int L_XS = 0;
constexpr int L_B = 73728;
constexpr int L_C = 92160;
constexpr int L_M = 109568;
constexpr int L_DT = 128000;
constexpr int L_AC = 130048;
constexpr int L_RED = 132096;

__device__ __forceinline__ int tr_off(int row, int tok) { return row * 72 + ((((tok >> 3) ^ (row >> 3)) & 7) << 3) + (tok & 7); }
template <bool TRANS>
__device__ __forceinline__ void conv4_chunk(const bf16_t* src, int tb0, const float* cw, const float* cb, LAS bf16_t* dst, int row0, int tok0) {
    u32x4 raw[19];
#pragma unroll
    for (int j = 0; j < 11; ++j) raw[j] = *(const u32x4*)(src + (long)(j - 3) * PW);
    float w[4][8], bias[8];
#pragma unroll
    for (int k = 0; k < 4; ++k) { const f32x4 a = *(const f32x4*)(cw + k * 1536), b = *(const f32x4*)(cw + k * 1536 + 4);
        w[k][0] = a.x; w[k][1] = a.y; w[k][2] = a.z; w[k][3] = a.w; w[k][4] = b.x; w[k][5] = b.y; w[k][6] = b.z; w[k][7] = b.w; }
    { const f32x4 a = *(const f32x4*)cb, b = *(const f32x4*)(cb + 4); bias[0] = a.x; bias[1] = a.y; bias[2] = a.z; bias[3] = a.w; bias[4] = b.x; bias[5] = b.y; bias[6] = b.z; bias[7] = b.w; }
    asm volatile("" ::: "memory");
    if (tb0 == 0) { raw[0] = (u32x4){0u, 0u, 0u, 0u}; raw[1] = raw[0]; raw[2] = raw[0]; }
    float r0[8], r1[8], r2[8], prev[8];
    unsigned pk[8][2];
    unpack8(raw[0], r0); unpack8(raw[1], r1); unpack8(raw[2], r2);
#pragma unroll
    for (int j = 0; j < 16; ++j) {
        if (j == 4) {
            asm volatile("" ::: "memory");
#pragma unroll
            for (int jj = 11; jj < 19; ++jj) raw[jj] = *(const u32x4*)(src + (long)(jj - 3) * PW);
            asm volatile("" ::: "memory");
        }
        float cur[8], o[8]; unpack8(raw[j + 3], cur);
#pragma unroll
        for (int e = 0; e < 8; ++e) { const float v = bias[e] + w[0][e] * r0[e] + w[1][e] * r1[e] + w[2][e] * r2[e] + w[3][e] * cur[e]; o[e] = silu_f(v); }
        if (TRANS) {
            if (j & 1) {
#pragma unroll
                for (int e = 0; e < 8; ++e) pk[e][(j & 3) >> 1] = cvt_pk_bf16(prev[e], o[e]);
            } else {
#pragma unroll
                for (int e = 0; e < 8; ++e) prev[e] = o[e];
            }
            if ((j & 3) == 3) {
                LAS bf16_t* bg = dst + row0 * 72 + (((((tok0 + j) >> 3) ^ (row0 >> 3)) & 7) << 3) + ((j - 3) & 7);
#pragma unroll
                for (int e = 0; e < 8; ++e) { u32x2 v; v.x = pk[e][0]; v.y = pk[e][1]; *(LAS u32x2*)(bg + e * 72) = v; }
            }
        } else { *(LAS u32x4*)(dst + (tok0 + j) * 136 + row0) = pack8(o); }
#pragma unroll
        for (int e = 0; e < 8; ++e) { r0[e] = r1[e]; r1[e] = r2[e]; r2[e] = cur[e]; }
    }
}

template <bool S1>
__device__ __forceinline__ void ssd_stage(const Args& a, int layer, LAS unsigned char* L, const bf16_t* PROJ, const float* DTB, int b, int c, int g, int tid) {
    const int rowbase = b * SEQ + c * 64;
    if (tid < 384) {
        const int wv = tid >> 6, ln = tid & 63;
        const float* cw = a.in[4] + (size_t)layer * 4 * 1536; const float* cb = a.in[5] + (size_t)layer * 1536;
        if (wv < 4) { const int q = ln, tg = wv, xc = 512 * g + 8 * q, tb0 = c * 64 + 16 * tg;
            const bf16_t* srow = PROJ + (size_t)(rowbase + 16 * tg) * PW + C_XBC;
            conv4_chunk<true>(srow + xc, tb0, cw + xc, cb + xc, (LAS bf16_t*)(L + L_XS), 8 * q, 16 * tg); }
        else if (wv == 4) { const int n = 8 * (ln & 15), tg = ln >> 4, xc = 1024 + 128 * g + n, tb0 = c * 64 + 16 * tg;
            const bf16_t* srow = PROJ + (size_t)(rowbase + 16 * tg) * PW + C_XBC;
            if (S1) conv4_chunk<true>(srow + xc, tb0, cw + xc, cb + xc, (LAS bf16_t*)(L + L_B), n, 16 * tg);
            else conv4_chunk<false>(srow + xc, tb0, cw + xc, cb + xc, (LAS bf16_t*)(L + L_B), n, 16 * tg); }
        else if (!S1) { const int n = 8 * (ln & 15), tg = ln >> 4, xc = 1280 + 128 * g + n, tb0 = c * 64 + 16 * tg;
            const bf16_t* srow = PROJ + (size_t)(rowbase + 16 * tg) * PW + C_XBC;
            conv4_chunk<false>(srow + xc, tb0, cw + xc, cb + xc, (LAS bf16_t*)(L + L_C), n, 16 * tg); }
    } else {
        const int t2 = tid - 384, tl = t2 & 63, hh = t2 >> 6;
        const f32x4 raw = *(const f32x4*)(DTB + (size_t)(rowbase + tl) * 16 + 8 * g + 4 * hh);
        LAS float* dtL = (LAS float*)(L + L_DT); LAS float* acL = (LAS float*)(L + L_AC);
#pragma unroll
        for (int i = 0; i < 4; ++i) {
            const int h = 8 * g + 4 * hh + i;
            const float v = raw[i] + a.in[6][layer * 16 + h];
            const float dt = fmaxf(v, 0.f) + log1pf(expf(-fabsf(v)));
            float cum = dt * (-expf(a.in[7][layer * 16 + h]));
#pragma unroll
            for (int off = 1; off < 64; off <<= 1) { const float t = __shfl_up(cum, off); if (tl >= off) cum += t; }
            dtL[(4 * hh + i) * 64 + tl] = dt; acL[(4 * hh + i) * 64 + tl] = cum;
        }
    }
}

__device__ __forceinline__ void conv_mixer(const Args& a, int layer, bf16_t* PROJ, int b, int c, int g, int tid) {
    const int q = tid & 63, tg = tid >> 6, ch = 512 * g + 8 * q;
    const int tb0 = c * 64 + 8 * tg;
    bf16_t* p = PROJ + (size_t)(b * SEQ + tb0) * PW + ch;
    u32x4 rp[10], rb[8];
#pragma unroll
    for (int j = 0; j < 10; ++j) rp[j] = *(const u32x4*)(p + (long)(j - 2) * PW + 2048);
#pragma unroll
    for (int j = 0; j < 8; ++j) rb[j] = *(const u32x4*)(p + (long)j * PW);
    const float* sw = a.in[3] + (size_t)layer * 3 * 1024 + ch;
    float w[3][8];
#pragma unroll
    for (int k = 0; k < 3; ++k) { const f32x4 x = *(const f32x4*)(sw + k * 1024), y = *(const f32x4*)(sw + k * 1024 + 4);
        w[k][0] = x.x; w[k][1] = x.y; w[k][2] = x.z; w[k][3] = x.w; w[k][4] = y.x; w[k][5] = y.y; w[k][6] = y.z; w[k][7] = y.w; }
    asm volatile("" ::: "memory");
    if (tb0 == 0) { rp[0] = (u32x4){0u, 0u, 0u, 0u}; rp[1] = rp[0]; }
    float p0[8], p1[8];
    unpack8(rp[0], p0); unpack8(rp[1], p1);
#pragma unroll
    for (int j = 0; j < 8; ++j) {
        float cur[8], ub[8], o[8];
        unpack8(rp[j + 2], cur); unpack8(rb[j], ub);
#pragma unroll
        for (int e = 0; e < 8; ++e) { o[e] = ub[e] * (w[0][e] * p0[e] + w[1][e] * p1[e] + w[2][e] * cur[e]); p0[e] = p1[e]; p1[e] = cur[e]; }
        *(u32x4*)(p + (long)j * PW) = pack8(o);
    }
}

__device__ __forceinline__ void phase_s1(const Args& a, int layer, LAS unsigned char* L, const int wave) {
    int lane_ = lane_id(); asm volatile("" : "+v"(lane_)); const int lane = lane_, tid0 = wave * 64 + lane;
    bf16_t* PROJ = (bf16_t*)(a.ws + WS_PROJ); const float* DTB = (const float*)(a.ws + WS_DT);
    bf16_t* ST = (bf16_t*)(a.ws + WS_ST); float* CD = (float*)(a.ws + WS_CD);
    const int fr = lane & 15, fq = lane >> 4;
    for (int u = blockIdx.x; u < NB * NCH * 2; u += gridDim.x) {
        const int b = u >> 8, c = (u & 255) >> 1, g = u & 1;
        int tid = tid0; asm volatile("" : "+v"(tid));
        conv_mixer(a, layer, PROJ, b, c, g, tid);
        ssd_stage<true>(a, layer, L, PROJ, DTB, b, c, g, tid);
        __syncthreads();
        const int h = 8 * g + wave;
        const LAS float* dtw = (const LAS float*)(L + L_DT) + wave * 64; const LAS float* acw = (const LAS float*)(L + L_AC) + wave * 64;
        const float aend = acw[63];
        bf16x8 xw[4][2];
#pragma unroll
        for (int ks = 0; ks < 2; ++ks) {
            float wv[8];
#pragma unroll
            for (int e = 0; e < 8; ++e) { const int l = 32 * ks + 8 * fq + e; wv[e] = dtw[l] * __expf(aend - acw[l]); }
#pragma unroll
            for (int pt = 0; pt < 4; ++pt) {
                const u32x4 raw = *(const LAS u32x4*)((const LAS bf16_t*)(L + L_XS) + tr_off(64 * wave + 16 * pt + fr, 32 * ks + 8 * fq));
                float x[8]; unpack8(raw, x);
#pragma unroll
                for (int e = 0; e < 8; ++e) x[e] *= wv[e];
                const u32x4 pk = pack8(x); xw[pt][ks] = __builtin_bit_cast(bf16x8, pk);
            }
        }
        bf16_t* stp = ST + (size_t)((b * NCH + c) * 16 + h) * 8192;
#pragma unroll
        for (int half = 0; half < 2; ++half) {
            f32x4 acc[4][4];
#pragma unroll
            for (int i = 0; i < 4; ++i)
#pragma unroll
                for (int j = 0; j < 4; ++j) acc[i][j] = (f32x4){0.f, 0.f, 0.f, 0.f};
#pragma unroll
            for (int nt = 0; nt < 4; ++nt)
#pragma unroll
                for (int ks = 0; ks < 2; ++ks) {
                    const bf16x8 bf = *(const LAS bf16x8*)((const LAS bf16_t*)(L + L_B) + tr_off(64 * half + 32 * (nt >> 1) + 8 * (fr >> 2) + 4 * (nt & 1) + (fr & 3), 32 * ks + 8 * fq));
#pragma unroll
                    for (int pt = 0; pt < 4; ++pt) acc[nt][pt] = __builtin_amdgcn_mfma_f32_16x16x32_f16(bf, xw[pt][ks], acc[nt][pt], 0, 0, 0);
                }
#pragma unroll
            for (int k2 = 0; k2 < 2; ++k2)
#pragma unroll
                for (int pt = 0; pt < 4; ++pt) { u32x4 w; w.x = cvt_pk_bf16(acc[2 * k2][pt][0], acc[2 * k2][pt][1]); w.y = cvt_pk_bf16(acc[2 * k2][pt][2], acc[2 * k2][pt][3]);
                    w.z = cvt_pk_bf16(acc[2 * k2 + 1][pt][0], acc[2 * k2 + 1][pt][1]); w.w = cvt_pk_bf16(acc[2 * k2 + 1][pt][2], acc[2 * k2 + 1][pt][3]);
                    *(u32x4*)(stp + (16 * pt + fr) * 128 + 64 * half + 32 * k2 + 8 * fq) = w; }
        }
        if (lane == 0) CD[(b * NCH + c) * 16 + h] = __expf(aend);
        __syncthreads();
    }
}

__device__ __forceinline__ void phase_s2(const Args& a, int layer, LAS unsigned char* L, const int wave) {
    int lane_ = lane_id(); asm volatile("" : "+v"(lane_)); const int lane = lane_, tid = wave * 64 + lane;
    if (wave < 4) {
        bf16_t* ST = (bf16_t*)(a.ws + WS_ST); const float* CD = (const float*)(a.ws + WS_CD);
        for (int wi = wave * gridDim.x + blockIdx.x; wi < 1024; wi += 4 * gridDim.x) {
            const int j = wi * 64 + lane, b = j >> 15, within = j & 32767, h = within >> 11;
            bf16_t* p = ST + (size_t)b * NCH * 131072 + (size_t)within * 4;
            const float* cd = CD + b * NCH * 16 + h;
            float H0 = 0.f, H1 = 0.f, H2 = 0.f, H3 = 0.f;
            for (int c0 = 0; c0 < NCH; c0 += 16) {
                u32x2 sv[16]; float d[16];
#pragma unroll
                for (int i = 0; i < 16; ++i) { sv[i] = *(const u32x2*)(p + (size_t)(c0 + i) * 131072); d[i] = cd[(c0 + i) * 16]; }
                asm volatile("" ::: "memory");
#pragma unroll
                for (int i = 0; i < 16; ++i) {
                    u32x2 o; o.x = cvt_pk_bf16(H0, H1); o.y = cvt_pk_bf16(H2, H3);
                    *(u32x2*)(p + (size_t)(c0 + i) * 131072) = o;
                    H0 = H0 * d[i] + bf_lo(sv[i].x); H1 = H1 * d[i] + bf_hi(sv[i].x); H2 = H2 * d[i] + bf_lo(sv[i].y); H3 = H3 * d[i] + bf_hi(sv[i].y);
                }
            }
        }
    } else if (layer + 1 < DEPTH) {
        convert_layer(a, layer + 1, a.ws + WS_WB + (size_t)((layer + 1) & 1) * WB_BYTES, (LAS float*)(L + wave * 16384), (wave - 4) * gridDim.x + blockIdx.x, 4 * gridDim.x, lane, (gridDim.x == 256) ? CONV_SPLIT : 0);
    }
}

__device__ __forceinline__ void phase_s3(const Args& a, int layer, LAS unsigned char* L, const int wave) {
    int lane_ = lane_id(); asm volatile("" : "+v"(lane_)); const int lane = lane_, tid0 = wave * 64 + lane;
    bf16_t* PROJ = (bf16_t*)(a.ws + WS_PROJ); const float* DTB = (const float*)(a.ws + WS_DT);
    const bf16_t* ST = (const bf16_t*)(a.ws + WS_ST);
    const int fr = lane & 15, fq = lane >> 4;
    for (int u = blockIdx.x; u < NB * NCH * 2; u += gridDim.x) {
        const int b = u >> 8, c = (u & 255) >> 1, g = u & 1;
        int tid = tid0; asm volatile("" : "+v"(tid));
        ssd_stage<false>(a, layer, L, PROJ, DTB, b, c, g, tid);
        __syncthreads();
        const int h = 8 * g + wave, rowbase = b * SEQ + c * 64;
        const LAS float* dtw = (const LAS float*)(L + L_DT) + wave * 64; const LAS float* acw = (const LAS float*)(L + L_AC) + wave * 64;
        const LAS bf16_t* xsT = (const LAS bf16_t*)(L + L_XS);
        const LAS bf16_t* Bl = (const LAS bf16_t*)(L + L_B); const LAS bf16_t* Cl = (const LAS bf16_t*)(L + L_C);
        LAS bf16_t* Mw = (LAS bf16_t*)(L + L_M) + wave * 1152;
        float al[4];
#pragma unroll
        for (int lt = 0; lt < 4; ++lt) al[lt] = acw[16 * lt + fr];
        f32x4 acc[4][4];
#pragma unroll
        for (int i = 0; i < 4; ++i)
#pragma unroll
            for (int j = 0; j < 4; ++j) acc[i][j] = (f32x4){0.f, 0.f, 0.f, 0.f};
        const bf16_t* prevp = ST + (size_t)((b * NCH + c) * 16 + h) * 8192;
        {
            bf16x8 pf[4][4];
#pragma unroll
            for (int ks = 0; ks < 4; ++ks)
#pragma unroll
                for (int pt = 0; pt < 4; ++pt) pf[ks][pt] = *(const bf16x8*)(prevp + (32 * (pt >> 1) + 8 * (fr >> 2) + 4 * (pt & 1) + (fr & 3)) * 128 + 32 * ks + 8 * fq);
            asm volatile("" ::: "memory");
#pragma unroll
            for (int ks = 0; ks < 4; ++ks)
#pragma unroll
                for (int lt = 0; lt < 4; ++lt) { const bf16x8 cf = *(const LAS bf16x8*)(Cl + (16 * lt + fr) * 136 + 32 * ks + 8 * fq);
#pragma unroll
                    for (int pt = 0; pt < 4; ++pt) acc[lt][pt] = __builtin_amdgcn_mfma_f32_16x16x32_f16(pf[ks][pt], cf, acc[lt][pt], 0, 0, 0); }
        }
        u32x4 zr[4][2];
#pragma unroll
        for (int lt = 0; lt < 4; ++lt)
#pragma unroll
            for (int k2 = 0; k2 < 2; ++k2) zr[lt][k2] = *(const u32x4*)(PROJ + (size_t)(rowbase + 16 * lt + fr) * PW + 1024 + 64 * h + 32 * k2 + 8 * fq);
        asm volatile("" ::: "memory");
#pragma unroll
        for (int lt = 0; lt < 4; ++lt) { const float e = __expf(al[lt]);
#pragma unroll
            for (int pt = 0; pt < 4; ++pt) acc[lt][pt] = acc[lt][pt] * e; }
#pragma unroll
        for (int lt = 0; lt < 4; ++lt) {
            bf16x8 cf[4];
#pragma unroll
            for (int ks = 0; ks < 4; ++ks) cf[ks] = *(const LAS bf16x8*)(Cl + (16 * lt + fr) * 136 + 32 * ks + 8 * fq);
#pragma unroll
            for (int st = 0; st < 4; ++st) {
                f32x4 m = (f32x4){0.f, 0.f, 0.f, 0.f};
                if (st <= lt) {
                    f32x4 sc = (f32x4){0.f, 0.f, 0.f, 0.f};
#pragma unroll
                    for (int ks = 0; ks < 4; ++ks) { const bf16x8 bfr = *(const LAS bf16x8*)(Bl + (16 * st + fr) * 136 + 32 * ks + 8 * fq); sc = __builtin_amdgcn_mfma_f32_16x16x32_f16(bfr, cf[ks], sc, 0, 0, 0); }
#pragma unroll
                    for (int r = 0; r < 4; ++r) { const int s = 16 * st + 4 * fq + r, l = 16 * lt + fr; const float v = sc[r] * __expf(al[lt] - acw[s]) * dtw[s]; m[r] = (s <= l) ? v : 0.f; }
                }
                u32x2 w; w.x = cvt_pk_bf16(m[0], m[1]); w.y = cvt_pk_bf16(m[2], m[3]);
                *(LAS u32x2*)(Mw + fr * 72 + 16 * st + 4 * fq) = w;
            }
            asm volatile("s_waitcnt lgkmcnt(0)" ::: "memory");
#pragma unroll
            for (int ks = 0; ks < 2; ++ks) { const bf16x8 mf = *(const LAS bf16x8*)(Mw + fr * 72 + 32 * ks + 8 * fq);
#pragma unroll
                for (int pt = 0; pt < 4; ++pt) { const bf16x8 xf = *(const LAS bf16x8*)(xsT + tr_off(64 * wave + 32 * (pt >> 1) + 8 * (fr >> 2) + 4 * (pt & 1) + (fr & 3), 32 * ks + 8 * fq)); acc[lt][pt] = __builtin_amdgcn_mfma_f32_16x16x32_f16(xf, mf, acc[lt][pt], 0, 0, 0); } }
            asm volatile("s_waitcnt lgkmcnt(0)" ::: "memory");
        }
        const float dsk = a.in[8][layer * 16 + h];
        LAS float* red = (LAS float*)(L + L_RED);
#pragma unroll
        for (int lt = 0; lt < 4; ++lt) {
            const int l = 16 * lt + fr; float ss = 0.f;
#pragma unroll
            for (int k2 = 0; k2 < 2; ++k2) {
                float zz[8]; unpack8(zr[lt][k2], zz);
#pragma unroll
                for (int o2 = 0; o2 < 2; ++o2)
#pragma unroll
                    for (int r = 0; r < 4; ++r) { const int pt = 2 * k2 + o2, p = 32 * k2 + 8 * fq + 4 * o2 + r;
                        const float xs = bf2f(xsT[tr_off(64 * wave + p, l)]); const float y = acc[lt][pt][r] + dsk * xs; const float gt = y * silu_f(zz[4 * o2 + r]); acc[lt][pt][r] = gt; ss += gt * gt; }
            }
            ss += __shfl_xor(ss, 16); ss += __shfl_xor(ss, 32);
            if (fq == 0) red[wave * 64 + l] = ss;
        }
        __syncthreads();
        const float* nw = a.in[9] + (size_t)layer * 1024 + 64 * h;
#pragma unroll
        for (int lt = 0; lt < 4; ++lt) {
            const int l = 16 * lt + fr; float tot = 0.f;
#pragma unroll
            for (int w8 = 0; w8 < 8; ++w8) tot += red[w8 * 64 + l];
            const float rs = rsqrtf(tot * (1.f / 512.f) + EPS);
#pragma unroll
            for (int k2 = 0; k2 < 2; ++k2) {
                const int pb = 32 * k2 + 8 * fq; const f32x4 n0 = *(const f32x4*)(nw + pb), n1 = *(const f32x4*)(nw + pb + 4);
                const f32x4 o0 = acc[lt][2 * k2] * rs * n0, o1 = acc[lt][2 * k2 + 1] * rs * n1;
                u32x4 w; w.x = cvt_pk_bf16(o0[0], o0[1]); w.y = cvt_pk_bf16(o0[2], o0[3]); w.z = cvt_pk_bf16(o1[0], o1[1]); w.w = cvt_pk_bf16(o1[2], o1[3]);
                *(u32x4*)(PROJ + (size_t)(rowbase + l) * PW + 1024 + 64 * h + pb) = w;
            }
        }
        __syncthreads();
    }
}

#define FUSE_FINAL (N_LAUNCH_MODE == 1)
#ifndef N_LAUNCH_MODE
#define N_LAUNCH_MODE 1
#endif
constexpr int NPHASE = 2 + 7 * DEPTH;

__global__ void __launch_bounds__(512, 2) trunk_fwd(Args args) {
    extern __shared__ __attribute__((aligned(16))) unsigned char lds_raw[];
    LAS unsigned char* L = (LAS unsigned char*)lds_raw;
    const int wave = __builtin_amdgcn_readfirstlane(threadIdx.x >> 6);
#define lane lane_id()
#define tid (wave * 64 + lane_id())
    const int G = gridDim.x;
    const int lo = args.ph_lo, hi = args.ph_hi;
    unsigned char* ws = args.ws;
    bf16_t* PROJ = (bf16_t*)(ws + WS_PROJ); bf16_t* HID = PROJ; bf16_t* XB = (bf16_t*)(ws + WS_XB);
    float* DTB = (float*)(ws + WS_DT); float* SSQ = (float*)(ws + WS_SSQ);
    float* X = args.out;
#define IN(k) (lo <= (k) && (k) < hi)
    volatile LAS unsigned* MISC = (volatile LAS unsigned*)(L + L_MISC);
    if (tid < 4) MISC[tid] = 0u;
    __syncthreads();
    XcdBarrier bar; bar.bar = (unsigned*)(ws + WS_BAR); bar.x = 0; bar.st = MISC;
    if (hi - lo > 1) bar = xcd_barrier_post((unsigned*)(ws + WS_BAR), MISC);
#define SEAM(k) do { if (IN(k) && IN((k) + 1)) xcd_barrier(bar); } while (0)
    if (IN(0)) {
        const int gw = blockIdx.x * 8 + wave, NGW = G * 8;
        convert_layer(args, 0, ws + WS_WB, (LAS float*)(L + wave * 16384), gw, NGW, lane);
        const float* x = args.in[0];
        for (int m = gw; m < M; m += 2 * NGW) {
            const int m2 = (m + NGW < M) ? m + NGW : m;
            const f32x4* xr = (const f32x4*)(x + (size_t)m * DM) + lane; const f32x4* xr2 = (const f32x4*)(x + (size_t)m2 * DM) + lane;
            float s = 0.f, s2 = 0.f; f32x4 v[4], v2[4];
#pragma unroll
            for (int j = 0; j < 4; ++j) { v[j] = xr[64 * j]; v2[j] = xr2[64 * j]; }
#pragma unroll
            for (int j = 0; j < 4; ++j) { s += (v[j].x * v[j].x + v[j].y * v[j].y) + (v[j].z * v[j].z + v[j].w * v[j].w); s2 += (v2[j].x * v2[j].x + v2[j].y * v2[j].y) + (v2[j].z * v2[j].z + v2[j].w * v2[j].w); }
            s = wave_sum(s); s2 = wave_sum(s2);
            u32x2* o = (u32x2*)(XB + (size_t)m * DM) + lane; u32x2* o2 = (u32x2*)(XB + (size_t)m2 * DM) + lane;
#pragma unroll
            for (int j = 0; j < 4; ++j) { u32x2 w; w.x = cvt_pk_bf16(v[j].x, v[j].y); w.y = cvt_pk_bf16(v[j].z, v[j].w); o[64 * j] = w;
                                          u32x2 w2; w2.x = cvt_pk_bf16(v2[j].x, v2[j].y); w2.y = cvt_pk_bf16(v2[j].z, v2[j].w); o2[64 * j] = w2; }
            if (lane < 16) { SSQ[(size_t)m * 16 + lane] = (lane == 0) ? s : 0.f; SSQ[(size_t)m2 * 16 + lane] = (lane == 0) ? s2 : 0.f; }
        }
    }
    SEAM(0);
    for (int layer = 0; layer < DEPTH; ++layer) {
        const int pb = 1 + 7 * layer;
        unsigned char* wb = ws + WS_WB + (size_t)(layer & 1) * WB_BYTES;
        if (IN(pb + 0)) {
            pg8::Gemm g{XB, (const bf16_t*)(wb + WB_IN), M, INP, DM, DM}; pg8::StaticOrder S; S.init(M, INP, G, (int)blockIdx.x);
            EpiInProj E{PROJ, DTB, SSQ};
            pg8::gemm_phase<EpiInProj, true>(L, g, S, E, wave);
            if (G == 256 && blockIdx.x >= 192 && layer + 1 < DEPTH)
                convert_layer(args, layer + 1, ws + WS_WB + (size_t)((layer + 1) & 1) * WB_BYTES, (LAS float*)(L + wave * 16384), wave * 64 + ((int)blockIdx.x - 192), 512, lane_id(), 0, CONV_SPLIT);
        }
        SEAM(pb + 0);
        if (IN(pb + 1)) phase_s1(args, layer, L, wave);
        SEAM(pb + 1);
        if (IN(pb + 2)) phase_s2(args, layer, L, wave);
        SEAM(pb + 2);
        if (IN(pb + 3)) phase_s3(args, layer, L, wave);
        SEAM(pb + 3);
        if (IN(pb + 4)) {
            pg8::Gemm g{PROJ, (const bf16_t*)(wb + WB_OUT), M, DM, MIXW, PW}; pg8::StaticOrder S; S.init(M, DM, G, (int)blockIdx.x);
            EpiResid E{XB, SSQ};
            pg8::gemm_phase<EpiResid, true>(L, g, S, E, wave);
        }
        SEAM(pb + 4);
        if (IN(pb + 5)) {
            pg8::Gemm g{XB, (const bf16_t*)(wb + WB_UP), M, FF, DM, DM}; pg8::StaticOrder S; S.init(M, FF, G, (int)blockIdx.x);
            EpiUp E{HID, SSQ};
            pg8::gemm_phase<EpiUp, true>(L, g, S, E, wave);
        }
        SEAM(pb + 5);
        if (IN(pb + 6)) {
            pg8::Gemm g{HID, (const bf16_t*)(wb + WB_DN), M, DM, FF, FF}; pg8::StaticOrder S; S.init(M, DM, G, (int)blockIdx.x);
            if (FUSE_FINAL && layer == DEPTH - 1 && G == 256) { EpiFinal E{XB, X, SSQ, (unsigned*)(ws + WS_BAR) + 4096, args.in[14]}; pg8::gemm_phase<EpiFinal, true>(L, g, S, E, wave); }
            else { EpiResid E{XB, SSQ}; pg8::gemm_phase<EpiResid, true>(L, g, S, E, wave); }
        }
        if (!(FUSE_FINAL && layer == DEPTH - 1 && G == 256)) SEAM(pb + 6);
    }
    if (IN(NPHASE - 1) && !(FUSE_FINAL && G == 256)) {
        const int gw = blockIdx.x * 8 + wave, NGW = G * 8;
        const f32x4* fw = (const f32x4*)args.in[14];
        for (int m = gw; m < M; m += 2 * NGW) {
            const int m2 = (m + NGW < M) ? m + NGW : m;
            const u32x4* xr = (const u32x4*)(XB + (size_t)m * DM); const u32x4* xr2 = (const u32x4*)(XB + (size_t)m2 * DM);
            u32x4 v[2], v2[2];
#pragma unroll
            for (int j = 0; j < 2; ++j) { v[j] = xr[lane + 64 * j]; v2[j] = xr2[lane + 64 * j]; }
            const float rs = row_rstd(SSQ, m), rs2 = row_rstd(SSQ, m2);
            f32x4* o = (f32x4*)(X + (size_t)m * DM); f32x4* o2 = (f32x4*)(X + (size_t)m2 * DM);
#pragma unroll
            for (int j = 0; j < 2; ++j) {
                const int e = 2 * (lane + 64 * j); const f32x4 w0 = fw[e], w1 = fw[e + 1];
                float a[8], b[8]; unpack8(v[j], a); unpack8(v2[j], b);
                o[e] = (f32x4){a[0], a[1], a[2], a[3]} * rs * w0; o[e + 1] = (f32x4){a[4], a[5], a[6], a[7]} * rs * w1;
                o2[e] = (f32x4){b[0], b[1], b[2], b[3]} * rs2 * w0; o2[e + 1] = (f32x4){b[4], b[5], b[6], b[7]} * rs2 * w1;
            }
        }
    }
#undef IN
#undef SEAM
#undef lane
#undef tid
}

extern "C" void kernel_launch(void* const* d_in, const int* in_sizes, int n_in, void* d_out, int out_size, void* d_ws, size_t ws_size, hipStream_t stream) {
    static int grid = 0;
    if (grid == 0) {
        if (n_in != 15 || out_size != M * DM || ws_size < WS_END) { fprintf(stderr, "kernel_launch: unexpected shapes (n_in %d out %d ws %zu)\n", n_in, out_size, ws_size); grid = -1; return; }
        int dev = 0, cus = 0, per_cu = 0;
        hipGetDevice(&dev); hipDeviceGetAttribute(&cus, hipDeviceAttributeMultiprocessorCount, dev);
        if (hipFuncSetAttribute((const void*)trunk_fwd, hipFuncAttributeMaxDynamicSharedMemorySize, LDS_BYTES) != hipSuccess) { fprintf(stderr, "kernel_launch: hipFuncSetAttribute failed\n"); grid = -1; return; }
        if (hipOccupancyMaxActiveBlocksPerMultiprocessor(&per_cu, (const void*)trunk_fwd, 512, LDS_BYTES) != hipSuccess || per_cu < 1) { fprintf(stderr, "kernel_launch: occupancy query says %d\n", per_cu); per_cu = 1; }
        (void)hipGetLastError();
        grid = cus;
    }
    if (grid < 0) return;
    if (hipMemsetAsync((char*)d_ws + WS_BAR, 0, BAR_BYTES, stream) != hipSuccess) { fprintf(stderr, "kernel_launch: memset failed\n"); return; }
    Args a{};
    for (int i = 0; i < 15; ++i) a.in[i] = (const float*)d_in[i];
    a.out = (float*)d_out; a.ws = (unsigned char*)d_ws;
#if N_LAUNCH_MODE == 1
    a.ph_lo = 0; a.ph_hi = NPHASE;
    void* kargs[] = {&a};
    hipError_t e = hipLaunchCooperativeKernel((const void*)trunk_fwd, dim3(grid), dim3(512), kargs, LDS_BYTES, stream);
    if (e != hipSuccess) fprintf(stderr, "cooperative launch failed: %s (grid %d)\n", hipGetErrorString(e), grid);
#else
    for (int p = 0; p < NPHASE; ++p) { a.ph_lo = p; a.ph_hi = p + 1; hipLaunchKernelGGL(trunk_fwd, dim3(grid), dim3(512), LDS_BYTES, stream, a); }
#endif
}
```

```cpp
#include <hip/hip_runtime.h>
#include <hip/hip_cooperative_groups.h>
#include <cstdio>
#include <cstdint>
namespace cg = cooperative_groups;

#define LAS __attribute__((address_space(3)))
typedef unsigned short bf16_t;
typedef _Float16 bf16x8 __attribute__((ext_vector_type(8)));
typedef _Float16 h16x2 __attribute__((ext_vector_type(2)));
typedef float f32x4 __attribute__((ext_vector_type(4)));
typedef float f32x2 __attribute__((ext_vector_type(2)));
typedef unsigned u32x4 __attribute__((ext_vector_type(4)));
typedef unsigned u32x2 __attribute__((ext_vector_type(2)));

constexpr int DM = 1024, NB = 2, SEQ = 8192, DEPTH = 4, M = NB * SEQ;
constexpr int NCH = SEQ / 64;
constexpr int INC = 5648, INP = 5888;
constexpr int PW = 4608;
constexpr int C_XBC = 3072;
constexpr int FF = 4096, MIXW = 2048;
constexpr float EPS = 1e-5f;

constexpr size_t MiB = 1u << 20;
constexpr size_t WS_WB = 0, WB_BYTES = 32 * MiB;
constexpr size_t WB_IN = 0, WB_OUT = 12 * MiB, WB_UP = 16 * MiB, WB_DN = 24 * MiB;
constexpr size_t WS_PROJ = 64 * MiB;
constexpr size_t WS_XB = 240 * MiB;
constexpr size_t WS_ST = 272 * MiB;
constexpr size_t WS_DT = 336 * MiB;
constexpr size_t WS_SSQ = 337 * MiB;
constexpr size_t WS_CD = 338 * MiB;
constexpr size_t WS_BAR = 338 * MiB + 65536;
constexpr size_t BAR_BYTES = 32768;
constexpr size_t WS_END = 339 * MiB;

constexpr int LDS_BYTES = 147456 + 256;
constexpr int L_SSQ = 131072, L_MISC = 147456;

__device__ __forceinline__ unsigned cvt_pk_bf16(float lo, float hi) { h16x2 v; v.x = (_Float16)__builtin_amdgcn_fmed3f(lo, -65504.f, 65504.f); v.y = (_Float16)__builtin_amdgcn_fmed3f(hi, -65504.f, 65504.f); return __builtin_bit_cast(unsigned, v); }
__device__ __forceinline__ float bf_lo(unsigned w) { return (float)__builtin_bit_cast(h16x2, w).x; }
__device__ __forceinline__ float bf_hi(unsigned w) { return (float)__builtin_bit_cast(h16x2, w).y; }
__device__ __forceinline__ float bf2f(bf16_t h) { return (float)__builtin_bit_cast(_Float16, h); }
__device__ __forceinline__ void unpack8(const u32x4 r, float (&o)[8]) { o[0] = bf_lo(r.x); o[1] = bf_hi(r.x); o[2] = bf_lo(r.y); o[3] = bf_hi(r.y); o[4] = bf_lo(r.z); o[5] = bf_hi(r.z); o[6] = bf_lo(r.w); o[7] = bf_hi(r.w); }
__device__ __forceinline__ u32x4 pack8(const float (&o)[8]) { u32x4 w; w.x = cvt_pk_bf16(o[0], o[1]); w.y = cvt_pk_bf16(o[2], o[3]); w.z = cvt_pk_bf16(o[4], o[5]); w.w = cvt_pk_bf16(o[6], o[7]); return w; }
__device__ __forceinline__ int lane_id() { int l; asm volatile("v_mbcnt_lo_u32_b32 %0, -1, 0\n\tv_mbcnt_hi_u32_b32 %0, -1, %0" : "=v"(l)); return l; }
__device__ __forceinline__ float silu_f(float x) { return x * __builtin_amdgcn_rcpf(1.f + __expf(-x)); }

__device__ __forceinline__ float row_rstd(const float* ssqp, int row) {
    const f32x4* p = (const f32x4*)(ssqp + (size_t)row * 16);
    const f32x4 a = p[0], b = p[1], c = p[2], d = p[3];
    const float s = (((a.x + a.y) + (a.z + a.w)) + ((b.x + b.y) + (b.z + b.w))) + (((c.x + c.y) + (c.z + c.w)) + ((d.x + d.y) + (d.z + d.w)));
    return rsqrtf(s * (1.f / 1024.f) + EPS);
}

__device__ __forceinline__ float row_rstd_lds(LAS unsigned char* lds, int rl) {
    const LAS f32x4* p = (const LAS f32x4*)(lds + 131072 + rl * 64);
    const f32x4 a = p[0], b = p[1], c = p[2], d = p[3];
    const float s = (((a.x + a.y) + (a.z + a.w)) + ((b.x + b.y) + (b.z + b.w))) + (((c.x + c.y) + (c.z + c.w)) + ((d.x + d.y) + (d.z + d.w)));
    return rsqrtf(s * (1.f / 1024.f) + EPS);
}

namespace pg8 {
constexpr int BM = 256, BK = 64, HALF = 128, HTB = HALF * BK * 2, STAGE_BYTES = 8 * HTB, NXCD = 8, WGM = 8;
__host__ __device__ __forceinline__ int lds_byte(int r, int c) { const int st = (r >> 4) * 2 + (c >> 5), rr = r & 15, cc = c & 31, ob = rr * 64 + cc * 2; return st * 1024 + (ob ^ (((ob >> 9) & 1) << 5)); }
__host__ __device__ __forceinline__ void stage_rc(int b, int& R, int& C) { const int st = b / 1024, sb = b % 1024, swz = sb ^ (((sb >> 9) & 1) << 5); R = (st >> 1) * 16 + swz / 64; C = (st & 1) * 32 + (swz % 64) / 2; }
__host__ __device__ __forceinline__ int perm32(int rho) { const int n = rho >> 4, i = rho & 15; return 8 * (i >> 2) + 4 * n + (i & 3); }
struct Unit { int pm, pn; };
struct Gemm { const bf16_t* A; const bf16_t* Bt; int M, N, K, lda; };
struct StaticOrder {
    int nM, nN, nwg, G, c;
    __host__ __device__ void init(int M_, int N_, int G_, int c_) { nM = M_ / BM; nN = N_ / BM; nwg = nM * nN; G = G_; c = c_; }
    __host__ __device__ bool next(int i, Unit& u) const {
        const long L = (long)i * G + c; if (L >= nwg) return false;
        int wgid = (int)L; { const int q = nwg / NXCD, r = nwg % NXCD, xcd = wgid % NXCD, off = wgid / NXCD; wgid = (xcd < r ? xcd * (q + 1) : r * (q + 1) + (xcd - r) * q) + off; }
        const int nig = WGM * nN, gid = wgid / nig, fm = gid * WGM, gsz = (nM - fm) < WGM ? (nM - fm) : WGM;
        u.pm = fm + ((wgid % nig) % gsz); u.pn = (wgid % nig) / gsz; return true;
    }
};
template <class Epi, bool ALIGN_EPI>
__device__ __forceinline__ void gemm_phase(LAS unsigned char* lds, const Gemm g, const StaticOrder& S, const Epi& E, const int wave_) {
    int lane_ = lane_id(); asm volatile("" : "+v"(lane_));
    int wv_ = wave_; asm volatile("" : "+s"(wv_));
    const int wid = wv_, lane = lane_, tid = wid * 64 + lane, wr = wid >> 2, wc = wid & 3, fr = lane & 15, fq = lane >> 4;
    const int K = g.K, nt = K / BK, lda = g.lda;
    unsigned voffA[2], voffB[2];
#pragma unroll
    for (int i = 0; i < 2; ++i) { int R, C; stage_rc(tid * 16 + i * 8192, R, C); const int Rb = (R & ~31) + perm32(R & 31);
        voffA[i] = (unsigned)(R * lda + C) * 2u; voffB[i] = (unsigned)(Rb * K + C) * 2u; }
    const size_t kstep = (size_t)(BK * 2);
    const size_t hstepA = (size_t)HALF * lda * 2, hstepB = (size_t)HALF * K * 2;
    const size_t tstepA = 2 * hstepA, tstepB = 2 * hstepB;
    const unsigned ldsw = (unsigned)wid * 1024u;
    const int aoff = lds_byte(wr * 64 + fr, fq * 8), boff = lds_byte(wc * 32 + fr, fq * 8);
#define PG8_SA(b, h) (((b) * 2 + (h)) * HTB)
#define PG8_SB(b, h) ((4 + (b) * 2 + (h)) * HTB)
#define PG8_STAGE(bufoff, gbase, voff) do { _Pragma("unroll") for (int _i = 0; _i < 2; ++_i) \
        __builtin_amdgcn_global_load_lds((const unsigned*)((const char*)(gbase) + (voff)[_i]), (LAS unsigned*)(lds + (bufoff) + ldsw + _i * 8192), 16, 0, 0); } while (0)
#define PG8_LDA(dst, b, h) do { _Pragma("unroll") for (int m = 0; m < 4; ++m) _Pragma("unroll") for (int k = 0; k < 2; ++k) dst[m][k] = *(const LAS bf16x8*)(lds + PG8_SA(b, h) + aoff + m * 2048 + k * 1024); } while (0)
#define PG8_LDB(dst, b, h) do { _Pragma("unroll") for (int n = 0; n < 2; ++n) _Pragma("unroll") for (int k = 0; k < 2; ++k) dst[n][k] = *(const LAS bf16x8*)(lds + PG8_SB(b, h) + boff + n * 2048 + k * 1024); } while (0)
#define PG8_MMA(ai, bj, At, Bt) do { __builtin_amdgcn_s_setprio(1); _Pragma("unroll") for (int m = 0; m < 4; ++m) _Pragma("unroll") for (int n = 0; n < 2; ++n) _Pragma("unroll") for (int k = 0; k < 2; ++k) \
        acc[ai][bj][m][n] = __builtin_amdgcn_mfma_f32_16x16x32_f16(Bt[n][k], At[m][k], acc[ai][bj][m][n], 0, 0, 0); __builtin_amdgcn_s_setprio(0); } while (0)
#define PG8_WAIT_V(n) asm volatile("s_waitcnt vmcnt(" #n ")" ::: "memory")
#define PG8_WAIT_L(n) asm volatile("s_waitcnt lgkmcnt(" #n ")" ::: "memory")
#define PG8_BAR __builtin_amdgcn_s_barrier()
#define PG8_SCHED __builtin_amdgcn_sched_barrier(0)
#define PG8_SSQ_HOOK(U) do { const unsigned hook_lo = (unsigned)lane_id() * 16u; _Pragma("unroll") for (int _i = 0; _i < 2; ++_i) \
        __builtin_amdgcn_global_load_lds((const unsigned*)((const char*)E.ssqp + (size_t)((U).pm * BM + 32 * wid + 16 * _i) * 64 + hook_lo), (LAS unsigned*)(lds + L_SSQ + (32 * wid + 16 * _i) * 64), 16, 0, 0); } while (0)
    Unit cur, nxt; int ui = 0;
    if (!S.next(0, cur)) return;
    if constexpr (Epi::PREFETCH_SSQ) PG8_SSQ_HOOK(cur);
    f32x4 acc[2][2][4][2];
#pragma unroll
    for (int a = 0; a < 2; ++a)
#pragma unroll
        for (int b = 0; b < 2; ++b)
#pragma unroll
            for (int m = 0; m < 4; ++m)
#pragma unroll
                for (int n = 0; n < 2; ++n) acc[a][b][m][n] = (f32x4){0.f, 0.f, 0.f, 0.f};
    bf16x8 At[4][2], B0[2][2], B1[2][2];
    const char* cA = (const char*)g.A + (size_t)cur.pm * tstepA; const char* cB = (const char*)g.Bt + (size_t)cur.pn * tstepB;
    PG8_STAGE(PG8_SB(0, 0), cB, voffB); PG8_STAGE(PG8_SB(0, 1), cB + hstepB, voffB); PG8_STAGE(PG8_SA(0, 0), cA, voffA); PG8_STAGE(PG8_SA(0, 1), cA + hstepA, voffA);
    if (wr == 1) PG8_BAR;
    PG8_WAIT_V(2); PG8_BAR;
    PG8_STAGE(PG8_SB(1, 0), cB + kstep, voffB); PG8_STAGE(PG8_SA(1, 0), cA + kstep, voffA); PG8_STAGE(PG8_SB(1, 1), cB + hstepB + kstep, voffB);
    PG8_WAIT_V(6); PG8_BAR;
    for (;;) {
        const bool has_next = S.next(ui + 1, nxt);
        const char* nA = has_next ? (const char*)g.A + (size_t)nxt.pm * tstepA : cA; const char* nB = has_next ? (const char*)g.Bt + (size_t)nxt.pn * tstepB : cB;
        for (int t = 0; t < nt; t += 2) {
            const bool last = (t == nt - 2);
            const char* a1 = cA + (size_t)(t + 1) * kstep;
            const char* a2 = last ? nA : cA + (size_t)(t + 2) * kstep; const char* b2 = last ? nB : cB + (size_t)(t + 2) * kstep;
            const char* a3 = a2 + kstep; const char* b3 = b2 + kstep;
            PG8_LDB(B0, 0, 0); PG8_LDB(B1, 0, 1); PG8_SCHED; PG8_LDA(At, 0, 0); PG8_STAGE(PG8_SA(1, 1), a1 + hstepA, voffA);
            PG8_WAIT_V(8); PG8_WAIT_L(0); PG8_BAR; PG8_MMA(0, 0, At, B0); PG8_MMA(0, 1, At, B1); PG8_BAR; PG8_SCHED;
            PG8_LDA(At, 0, 1); PG8_STAGE(PG8_SB(0, 0), b2, voffB); PG8_STAGE(PG8_SB(0, 1), b2 + hstepB, voffB); PG8_STAGE(PG8_SA(0, 0), a2, voffA);
            PG8_WAIT_V(8); PG8_WAIT_L(0); PG8_BAR; PG8_MMA(1, 0, At, B0); PG8_MMA(1, 1, At, B1); PG8_BAR; PG8_SCHED;
            PG8_LDB(B0, 1, 0); PG8_LDB(B1, 1, 1); PG8_SCHED; PG8_LDA(At, 1, 0); PG8_STAGE(PG8_SA(0, 1), a2 + hstepA, voffA);
            PG8_WAIT_V(8); PG8_WAIT_L(0); PG8_BAR; PG8_MMA(0, 0, At, B0); PG8_MMA(0, 1, At, B1); PG8_BAR; PG8_SCHED;
            PG8_LDA(At, 1, 1); PG8_STAGE(PG8_SB(1, 0), b3, voffB); PG8_STAGE(PG8_SB(1, 1), b3 + hstepB, voffB); PG8_STAGE(PG8_SA(1, 0), a3, voffA);
            PG8_WAIT_V(8); PG8_WAIT_L(0); PG8_BAR; PG8_MMA(1, 0, At, B0); PG8_MMA(1, 1, At, B1); PG8_BAR; PG8_SCHED;
        }
        if constexpr (ALIGN_EPI) { if (wr == 0) PG8_BAR; }
        { const int l2 = lane_id(); E(acc, cur, wr, wc, l2 & 15, l2 >> 4, lds); }
        if (!has_next) break;
#pragma unroll
        for (int a = 0; a < 2; ++a)
#pragma unroll
            for (int b = 0; b < 2; ++b)
#pragma unroll
                for (int m = 0; m < 4; ++m)
#pragma unroll
                    for (int n = 0; n < 2; ++n) acc[a][b][m][n] = (f32x4){0.f, 0.f, 0.f, 0.f};
        cur = nxt; cA = nA; cB = nB; ++ui;
        if constexpr (Epi::PREFETCH_SSQ) { PG8_BAR; PG8_SSQ_HOOK(cur); }
        if constexpr (ALIGN_EPI) { if (wr == 1) PG8_BAR; }
    }
    PG8_WAIT_V(0);
    if constexpr (!ALIGN_EPI) { if (wr == 0) PG8_BAR; }
    PG8_BAR;
#undef PG8_SSQ_HOOK
#undef PG8_SA
#undef PG8_SB
#undef PG8_STAGE
#undef PG8_LDA
#undef PG8_LDB
#undef PG8_MMA
#undef PG8_WAIT_V
#undef PG8_WAIT_L
#undef PG8_BAR
#undef PG8_SCHED
}
}

struct EpiInProj {
    static constexpr bool PREFETCH_SSQ = true;
    bf16_t* P; float* DT; const float* ssqp;
    __device__ __forceinline__ void operator()(f32x4 (&acc)[2][2][4][2], const pg8::Unit& u, int wr, int wc, int fr, int fq, LAS unsigned char* lds) const {
        const int pn = u.pn, row0 = u.pm * 256 + wr * 64 + fr, cw0 = wc * 32 + 8 * fq;
#pragma unroll
        for (int ai = 0; ai < 2; ++ai)
#pragma unroll
            for (int m = 0; m < 4; ++m) {
                const int row = row0 + ai * 128 + m * 16; const float rs = row_rstd_lds(lds, ai * 128 + wr * 64 + m * 16 + fr);
                if (pn >= 8 && pn < 16) {
                    const float r2 = rs * rs;
                    const f32x4 v0 = acc[ai][0][m][0] * acc[ai][1][m][0] * r2, v1 = acc[ai][0][m][1] * acc[ai][1][m][1] * r2;
                    u32x4 w; w.x = cvt_pk_bf16(v0[0], v0[1]); w.y = cvt_pk_bf16(v0[2], v0[3]); w.z = cvt_pk_bf16(v1[0], v1[1]); w.w = cvt_pk_bf16(v1[2], v1[3]);
                    *(u32x4*)(P + (size_t)row * PW + 2048 + 128 * (pn - 8) + cw0) = w;
                } else {
#pragma unroll
                    for (int bj = 0; bj < 2; ++bj) {
                        const int gcol = pn * 256 + bj * 128 + cw0; const f32x4 v0 = acc[ai][bj][m][0] * rs, v1 = acc[ai][bj][m][1] * rs;
                        if (pn < 22) { u32x4 w; w.x = cvt_pk_bf16(v0[0], v0[1]); w.y = cvt_pk_bf16(v0[2], v0[3]); w.z = cvt_pk_bf16(v1[0], v1[1]); w.w = cvt_pk_bf16(v1[2], v1[3]);
                            *(u32x4*)(P + (size_t)row * PW + (pn < 8 ? gcol : gcol - 1024)) = w; }
                        else if (gcol < INC) { float* d = DT + (size_t)row * 16 + (gcol - 5632); *(f32x4*)d = v0; *(f32x4*)(d + 4) = v1; }
                    }
                }
            }
    }
};
struct EpiResid {
    static constexpr bool PREFETCH_SSQ = false;
    bf16_t* XB; float* ssqp;
    __device__ __forceinline__ void operator()(f32x4 (&acc)[2][2][4][2], const pg8::Unit& u, int wr, int wc, int fr, int fq, LAS unsigned char* lds) const {
        const int row0 = u.pm * 256 + wr * 64 + fr, col0 = u.pn * 256 + wc * 32 + 8 * fq;
#pragma unroll
        for (int ai = 0; ai < 2; ++ai) {
            u32x4 bs[4][2];
#pragma unroll
            for (int m = 0; m < 4; ++m)
#pragma unroll
                for (int bj = 0; bj < 2; ++bj) bs[m][bj] = *(const u32x4*)(XB + (size_t)(row0 + ai * 128 + m * 16) * DM + col0 + bj * 128);
            asm volatile("" ::: "memory");
#pragma unroll
            for (int m = 0; m < 4; ++m) {
                const int row = row0 + ai * 128 + m * 16; float ss = 0.f;
#pragma unroll
                for (int bj = 0; bj < 2; ++bj) {
                    const size_t off = (size_t)row * DM + col0 + bj * 128;
                    float b[8]; unpack8(bs[m][bj], b);
                    const f32x4 v0 = acc[ai][bj][m][0] + (f32x4){b[0], b[1], b[2], b[3]}, v1 = acc[ai][bj][m][1] + (f32x4){b[4], b[5], b[6], b[7]};
                    u32x4 w; w.x = cvt_pk_bf16(v0[0], v0[1]); w.y = cvt_pk_bf16(v0[2], v0[3]); w.z = cvt_pk_bf16(v1[0], v1[1]); w.w = cvt_pk_bf16(v1[2], v1[3]);
                    *(u32x4*)(XB + off) = w;
                    ss += ((v0[0] * v0[0] + v0[1] * v0[1]) + (v0[2] * v0[2] + v0[3] * v0[3])) + ((v1[0] * v1[0] + v1[1] * v1[1]) + (v1[2] * v1[2] + v1[3] * v1[3]));
                }
                ss += __shfl_xor(ss, 16); ss += __shfl_xor(ss, 32);
                if (fq == 0) ssqp[(size_t)row * 16 + u.pn * 4 + wc] = ss;
            }
        }
    }
};
struct EpiFinal {
    static constexpr bool PREFETCH_SSQ = false;
    const bf16_t* XB; float* out; float* ssqp; unsigned* cnt; const float* fw;
    __device__ __forceinline__ void operator()(f32x4 (&acc)[2][2][4][2], const pg8::Unit& u, int wr, int wc, int fr, int fq, LAS unsigned char* lds) const {
        const int row0 = u.pm * 256 + wr * 64 + fr, col0 = u.pn * 256 + wc * 32 + 8 * fq;
#pragma unroll
        for (int ai = 0; ai < 2; ++ai) {
            u32x4 bs[4][2];
#pragma unroll
            for (int m = 0; m < 4; ++m)
#pragma unroll
                for (int bj = 0; bj < 2; ++bj) bs[m][bj] = *(const u32x4*)(XB + (size_t)(row0 + ai * 128 + m * 16) * DM + col0 + bj * 128);
            asm volatile("" ::: "memory");
#pragma unroll
            for (int m = 0; m < 4; ++m) {
                const int row = row0 + ai * 128 + m * 16; float ss = 0.f;
#pragma unroll
                for (int bj = 0; bj < 2; ++bj) {
                    float b[8]; unpack8(bs[m][bj], b);
                    const f32x4 v0 = acc[ai][bj][m][0] + (f32x4){b[0], b[1], b[2], b[3]}, v1 = acc[ai][bj][m][1] + (f32x4){b[4], b[5], b[6], b[7]};
                    acc[ai][bj][m][0] = v0; acc[ai][bj][m][1] = v1;
                    ss += ((v0[0] * v0[0] + v0[1] * v0[1]) + (v0[2] * v0[2] + v0[3] * v0[3])) + ((v1[0] * v1[0] + v1[1] * v1[1]) + (v1[2] * v1[2] + v1[3] * v1[3]));
                }
                ss += __shfl_xor(ss, 16); ss += __shfl_xor(ss, 32);
                if (fq == 0) __hip_atomic_store(ssqp + (size_t)row * 16 + u.pn * 4 + wc, ss, __ATOMIC_RELAXED, __HIP_MEMORY_SCOPE_AGENT);
            }
        }
        asm volatile("s_waitcnt vmcnt(0)" ::: "memory");
        unsigned* pc = cnt + 64 * u.pm;
        const int ln = lane_id();
        if (ln == 0) __hip_atomic_fetch_add(pc, 1u, __ATOMIC_RELAXED, __HIP_MEMORY_SCOPE_AGENT);
        if (wr == 0 && wc == 0) { unsigned sp = 0u;
          while ((unsigned)__builtin_amdgcn_readfirstlane((int)__hip_atomic_load(pc, __ATOMIC_RELAXED, __HIP_MEMORY_SCOPE_AGENT)) < 32u) { if (++sp > (1u << 20)) break; __builtin_amdgcn_s_sleep(2); } }
        __builtin_amdgcn_s_barrier();
        __builtin_amdgcn_fence(__ATOMIC_ACQUIRE, "agent");
        asm volatile("s_waitcnt vmcnt(0)" ::: "memory");
#pragma unroll
        for (int ai = 0; ai < 2; ++ai)
#pragma unroll
            for (int m = 0; m < 4; ++m) {
                const int row = row0 + ai * 128 + m * 16;
                const f32x4 p4 = *(const f32x4*)(ssqp + (size_t)row * 16 + 4 * fq);
                float tot = (p4.x + p4.y) + (p4.z + p4.w); tot += __shfl_xor(tot, 16); tot += __shfl_xor(tot, 32);
                const float rs = rsqrtf(tot * (1.f / 1024.f) + EPS);
#pragma unroll
                for (int bj = 0; bj < 2; ++bj) {
                    const size_t off = (size_t)row * DM + col0 + bj * 128;
                    const f32x4 w0 = *(const f32x4*)(fw + col0 + bj * 128), w1 = *(const f32x4*)(fw + col0 + bj * 128 + 4);
                    *(f32x4*)(out + off) = acc[ai][bj][m][0] * rs * w0; *(f32x4*)(out + off + 4) = acc[ai][bj][m][1] * rs * w1;
                }
            }
    }
};
struct EpiUp {
    static constexpr bool PREFETCH_SSQ = true;
    bf16_t* H; const float* ssqp;
    __device__ __forceinline__ void operator()(f32x4 (&acc)[2][2][4][2], const pg8::Unit& u, int wr, int wc, int fr, int fq, LAS unsigned char* lds) const {
        const int row0 = u.pm * 256 + wr * 64 + fr, col0 = u.pn * 256 + wc * 32 + 8 * fq;
#pragma unroll
        for (int ai = 0; ai < 2; ++ai)
#pragma unroll
            for (int m = 0; m < 4; ++m) {
                const int row = row0 + ai * 128 + m * 16; const float rs = row_rstd_lds(lds, ai * 128 + wr * 64 + m * 16 + fr);
#pragma unroll
                for (int bj = 0; bj < 2; ++bj) {
                    f32x4 v0 = acc[ai][bj][m][0] * rs, v1 = acc[ai][bj][m][1] * rs;
#pragma unroll
                    for (int e = 0; e < 4; ++e) { const float a = fmaxf(v0[e], 0.f), b = fmaxf(v1[e], 0.f); v0[e] = a * a; v1[e] = b * b; }
                    u32x4 w; w.x = cvt_pk_bf16(v0[0], v0[1]); w.y = cvt_pk_bf16(v0[2], v0[3]); w.z = cvt_pk_bf16(v1[0], v1[1]); w.w = cvt_pk_bf16(v1[2], v1[3]);
                    *(u32x4*)(H + (size_t)row * FF + col0 + bj * 128) = w;
                }
            }
    }
};


#define XB_TMO      128
#define XB_XCNT(j)  (256  + 64 * (j))
#define XB_XSUB(j)  (1280 + 64 * (j))
#define XB_XGEN(j)  (2304 + 64 * (j))
#define XB_TOP      3328
#define XB_TOPGEN   3392
#define XCD_BAR_WORDS 3456
#define XB_SPIN_CAP (1u << 18)
__device__ __forceinline__ unsigned xb_ld(unsigned* p)              { return __hip_atomic_load(p, __ATOMIC_RELAXED, __HIP_MEMORY_SCOPE_AGENT); }
__device__ __forceinline__ unsigned xb_add(unsigned* p, unsigned v) { return __hip_atomic_fetch_add(p, v, __ATOMIC_RELAXED, __HIP_MEMORY_SCOPE_AGENT); }
__device__ __forceinline__ unsigned xb_xcc_id() { return (unsigned)__builtin_amdgcn_s_getreg((3 << 11) | 20) & 0xFu; }
#define XB_SPIN(cond, bar) do { unsigned _sp = 0; while (cond) { __builtin_amdgcn_s_sleep(1); \
    if ((++_sp & 255u) == 0u) { if (xb_ld(&(bar)[XB_TMO])) break; if (_sp > XB_SPIN_CAP) { atomicAdd(&(bar)[XB_TMO], 1u); break; } } } } while (0)
struct XcdBarrier { unsigned* bar; unsigned x; volatile LAS unsigned* st; };
__device__ __forceinline__ XcdBarrier xcd_barrier_post(unsigned* bar, volatile LAS unsigned* st) {
    XcdBarrier b; b.bar = bar; b.x = xb_xcc_id(); b.st = st;
    if (threadIdx.x == 0) (void)xb_add(&bar[XB_XCNT(b.x)], 1u);
    return b;
}
__device__ __forceinline__ void xcd_barrier_complete(unsigned* bar, unsigned x, unsigned& nloc, unsigned& nx) {
    const unsigned G = gridDim.x * gridDim.y * gridDim.z;
    unsigned sum, cnt, mine, sp = 0u;
    for (;;) {
        sum = 0u; cnt = 0u; mine = 0u;
#pragma unroll
        for (unsigned j = 0; j < 16; ++j) { const unsigned c = xb_ld(&bar[XB_XCNT(j)]); sum += c; cnt += (c > 0u) ? 1u : 0u; mine = (j == x) ? c : mine; }
        if (sum == G) break;
        __builtin_amdgcn_s_sleep(1);
        if ((++sp & 255u) == 0u) { if (xb_ld(&bar[XB_TMO])) break; if (sp > XB_SPIN_CAP) { atomicAdd(&bar[XB_TMO], 1u); break; } }
    }
    nloc = mine > 0u ? mine : 1u; nx = cnt > 0u ? cnt : 1u;
}
__device__ __forceinline__ void xcd_barrier(const XcdBarrier& b) {
    asm volatile("s_waitcnt vmcnt(0)" ::: "memory");
    __syncthreads();
    if (threadIdx.x == 0) {
        unsigned* bar = b.bar;
        __builtin_amdgcn_s_waitcnt(0);
        unsigned nloc = b.st[0], nx = b.st[1];
        if (nloc == 0u) { xcd_barrier_complete(bar, b.x, nloc, nx); b.st[0] = nloc; b.st[1] = nx; }
        const unsigned old = xb_add(&bar[XB_XSUB(b.x)], 1u);
        const unsigned gen = old / nloc;
        if (old + 1u == (gen + 1u) * nloc) {
            __builtin_amdgcn_fence(__ATOMIC_RELEASE, "agent");
            asm volatile("s_waitcnt vmcnt(0)" ::: "memory");
            const unsigned og = xb_add(&bar[XB_TOP], 1u);
            const unsigned tg = og / nx;
            if (og + 1u == (tg + 1u) * nx) xb_add(&bar[XB_TOPGEN], 1u);
            else XB_SPIN(xb_ld(&bar[XB_TOPGEN]) == tg, bar);
            __builtin_amdgcn_fence(__ATOMIC_ACQUIRE, "agent");
            xb_add(&bar[XB_XGEN(b.x)], 1u);
            asm volatile("s_waitcnt vmcnt(0)" ::: "memory");
        } else {
            XB_SPIN(xb_ld(&bar[XB_XGEN(b.x)]) == gen, bar);
            __builtin_amdgcn_fence(__ATOMIC_ACQUIRE, "agent");
            asm volatile("s_waitcnt vmcnt(0)" ::: "memory");
        }
    }
    __syncthreads();
}

struct Args { const float* in[15]; float* out; unsigned char* ws; int ph_lo, ph_hi; };

__device__ __forceinline__ float wave_sum(float v) {
#pragma unroll
    for (int o = 1; o < 64; o <<= 1) v += __shfl_xor(v, o);
    return v;
}

template <bool PERMROW>
__device__ __forceinline__ void transpose_item(const float* W, int K, int N, int nblk, bf16_t* WT, const float* scale, LAS float* scr, int item, int lane) {
    const int kb = item / nblk, nb = item % nblk, k0 = 64 * kb, n0 = 32 * nb;
    const int n = n0 + (lane & 31);
    const float* wp = W + (size_t)(k0 + (lane >> 5)) * N + n;
    float v[32];
    if (n < N) {
#pragma unroll
        for (int i = 0; i < 32; ++i) v[i] = wp[(size_t)(2 * i) * N];
    } else {
#pragma unroll
        for (int i = 0; i < 32; ++i) v[i] = 0.f;
    }
    const int c = lane & 7;
    f32x4 s0 = (f32x4){1.f, 1.f, 1.f, 1.f}, s1 = s0;
    if (scale) { s0 = *(const f32x4*)(scale + k0 + 8 * c); s1 = *(const f32x4*)(scale + k0 + 8 * c + 4); }
    asm volatile("" ::: "memory");
#pragma unroll
    for (int i = 0; i < 32; ++i) scr[(2 * i + (lane >> 5)) * 33 + (lane & 31)] = v[i];
    asm volatile("s_waitcnt lgkmcnt(0)" ::: "memory");
#pragma unroll
    for (int j = 0; j < 4; ++j) { const int nn = (lane >> 3) + 8 * j; const LAS float* sp = scr + (8 * c) * 33 + nn;
        u32x4 o; o.x = cvt_pk_bf16(sp[0 * 33] * s0.x, sp[1 * 33] * s0.y); o.y = cvt_pk_bf16(sp[2 * 33] * s0.z, sp[3 * 33] * s0.w); o.z = cvt_pk_bf16(sp[4 * 33] * s1.x, sp[5 * 33] * s1.y); o.w = cvt_pk_bf16(sp[6 * 33] * s1.z, sp[7 * 33] * s1.w);
        int row = n0 + nn;
        if (PERMROW) {
            if (row >= 1024 && row < 3072) { const int hsel = (row >= 2048) ? 1 : 0, ch = row - 1024 - 1024 * hsel; row = 2048 + 256 * (ch >> 7) + 128 * hsel + (ch & 127); }
            else if (row >= 3072 && row < 4096) row -= 2048; }
        *(u32x4*)(WT + (size_t)row * K + k0 + 8 * c) = o; }
    asm volatile("s_waitcnt lgkmcnt(0)" ::: "memory");
}
__device__ __forceinline__ void convert_layer(const Args& a, int layer, unsigned char* wb, LAS float* scr, int wi, int nw, int lane, int it_lo = 0, int it_hi = 1 << 30) {
    constexpr int I_IN = 16 * 177, I_OUT = 32 * 32, I_UP = 16 * 128, I_DN = 64 * 32;
    const float* w_in = a.in[2] + (size_t)layer * DM * INC; const float* w_out = a.in[10] + (size_t)layer * MIXW * DM;
    const float* w_up = a.in[12] + (size_t)layer * DM * FF; const float* w_dn = a.in[13] + (size_t)layer * FF * DM;
    const int it_end = (it_hi < I_IN + I_OUT + I_UP + I_DN) ? it_hi : I_IN + I_OUT + I_UP + I_DN;
    for (int it = it_lo + wi; it < it_end; it += nw) {
        int r = it;
        if (r < I_IN) { transpose_item<true>(w_in, DM, INC, 177, (bf16_t*)(wb + WB_IN), a.in[1] + layer * DM, scr, r, lane); continue; } r -= I_IN;
        if (r < I_OUT) { transpose_item<false>(w_out, MIXW, DM, 32, (bf16_t*)(wb + WB_OUT), nullptr, scr, r, lane); continue; } r -= I_OUT;
        if (r < I_UP) { transpose_item<false>(w_up, DM, FF, 128, (bf16_t*)(wb + WB_UP), a.in[11] + layer * DM, scr, r, lane); continue; } r -= I_UP;
        transpose_item<false>(w_dn, FF, DM, 32, (bf16_t*)(wb + WB_DN), nullptr, scr, r, lane);
    }
}

constexpr int CONV_SPLIT = 4608;
constexpr int L_XS = 0;
constexpr int L_B = 73728;
constexpr int L_C = 92160;
constexpr int L_M = 109568;
constexpr int L_DT = 128000;
constexpr int L_AC = 130048;
constexpr int L_RED = 132096;

__device__ __forceinline__ int tr_off(int row, int tok) { return row * 72 + ((((tok >> 3) ^ (row >> 3)) & 7) << 3) + (tok & 7); }
template <bool TRANS>
__device__ __forceinline__ void conv4_chunk(const bf16_t* src, int tb0, const float* cw, const float* cb, LAS bf16_t* dst, int row0, int tok0) {
    u32x4 raw[19];
#pragma unroll
    for (int j = 0; j < 11; ++j) raw[j] = *(const u32x4*)(src + (long)(j - 3) * PW);
    float w[4][8], bias[8];
#pragma unroll
    for (int k = 0; k < 4; ++k) { const f32x4 a = *(const f32x4*)(cw + k * 1536), b = *(const f32x4*)(cw + k * 1536 + 4);
        w[k][0] = a.x; w[k][1] = a.y; w[k][2] = a.z; w[k][3] = a.w; w[k][4] = b.x; w[k][5] = b.y; w[k][6] = b.z; w[k][7] = b.w; }
    { const f32x4 a = *(const f32x4*)cb, b = *(const f32x4*)(cb + 4); bias[0] = a.x; bias[1] = a.y; bias[2] = a.z; bias[3] = a.w; bias[4] = b.x; bias[5] = b.y; bias[6] = b.z; bias[7] = b.w; }
    asm volatile("" ::: "memory");
    if (tb0 == 0) { raw[0] = (u32x4){0u, 0u, 0u, 0u}; raw[1] = raw[0]; raw[2] = raw[0]; }
    float r0[8], r1[8], r2[8], prev[8];
    unsigned pk[8][2];
    unpack8(raw[0], r0); unpack8(raw[1], r1); unpack8(raw[2], r2);
#pragma unroll
    for (int j = 0; j < 16; ++j) {
        if (j == 0) {
            asm volatile("" ::: "memory");
#pragma unroll
            for (int jj = 11; jj < 19; ++jj) raw[jj] = *(const u32x4*)(src + (long)(jj - 3) * PW);
            asm volatile("" ::: "memory");
        }
        float cur[8], o[8]; unpack8(raw[j + 3], cur);
#pragma unroll
        for (int e = 0; e < 8; ++e) { const float v = bias[e] + w[0][e] * r0[e] + w[1][e] * r1[e] + w[2][e] * r2[e] + w[3][e] * cur[e]; o[e] = silu_f(v); }
        if (TRANS) {
            if (j & 1) {
#pragma unroll
                for (int e = 0; e < 8; ++e) pk[e][(j & 3) >> 1] = cvt_pk_bf16(prev[e], o[e]);
            } else {
#pragma unroll
                for (int e = 0; e < 8; ++e) prev[e] = o[e];
            }
            if ((j & 3) == 3) {
                LAS bf16_t* bg = dst + row0 * 72 + (((((tok0 + j) >> 3) ^ (row0 >> 3)) & 7) << 3) + ((j - 3) & 7);
#pragma unroll
                for (int e = 0; e < 8; ++e) { u32x2 v; v.x = pk[e][0]; v.y = pk[e][1]; *(LAS u32x2*)(bg + e * 72) = v; }
            }
        } else { *(LAS u32x4*)(dst + (tok0 + j) * 136 + row0) = pack8(o); }
#pragma unroll
        for (int e = 0; e < 8; ++e) { r0[e] = r1[e]; r1[e] = r2[e]; r2[e] = cur[e]; }
    }
}

template <bool S1>
__device__ __forceinline__ void ssd_stage(const Args& a, int layer, LAS unsigned char* L, const bf16_t* PROJ, const float* DTB, int b, int c, int g, int tid) {
    const int rowbase = b * SEQ + c * 64;
    if (tid < 384) {
        const int wv = tid >> 6, ln = tid & 63;
        const float* cw = a.in[4] + (size_t)layer * 4 * 1536; const float* cb = a.in[5] + (size_t)layer * 1536;
        if (wv < 4) { const int q = ln, tg = wv, xc = 512 * g + 8 * q, tb0 = c * 64 + 16 * tg;
            const bf16_t* srow = PROJ + (size_t)(rowbase + 16 * tg) * PW + C_XBC;
            conv4_chunk<true>(srow + xc, tb0, cw + xc, cb + xc, (LAS bf16_t*)(L + L_XS), 8 * q, 16 * tg); }
        else if (wv == 4) { const int n = 8 * (ln & 15), tg = ln >> 4, xc = 1024 + 128 * g + n, tb0 = c * 64 + 16 * tg;
            const bf16_t* srow = PROJ + (size_t)(rowbase + 16 * tg) * PW + C_XBC;
            if (S1) conv4_chunk<true>(srow + xc, tb0, cw + xc, cb + xc, (LAS bf16_t*)(L + L_B), n, 16 * tg);
            else conv4_chunk<false>(srow + xc, tb0, cw + xc, cb + xc, (LAS bf16_t*)(L + L_B), n, 16 * tg); }
        else if (!S1) { const int n = 8 * (ln & 15), tg = ln >> 4, xc = 1280 + 128 * g + n, tb0 = c * 64 + 16 * tg;
            const bf16_t* srow = PROJ + (size_t)(rowbase + 16 * tg) * PW + C_XBC;
            conv4_chunk<false>(srow + xc, tb0, cw + xc, cb + xc, (LAS bf16_t*)(L + L_C), n, 16 * tg); }
    } else {
        const int t2 = tid - 384, tl = t2 & 63, hh = t2 >> 6;
        const f32x4 raw = *(const f32x4*)(DTB + (size_t)(rowbase + tl) * 16 + 8 * g + 4 * hh);
        LAS float* dtL = (LAS float*)(L + L_DT); LAS float* acL = (LAS float*)(L + L_AC);
#pragma unroll
        for (int i = 0; i < 4; ++i) {
            const int h = 8 * g + 4 * hh + i;
            const float v = raw[i] + a.in[6][layer * 16 + h];
            const float dt = fmaxf(v, 0.f) + log1pf(expf(-fabsf(v)));
            float cum = dt * (-expf(a.in[7][layer * 16 + h]));
#pragma unroll
            for (int off = 1; off < 64; off <<= 1) { const float t = __shfl_up(cum, off); if (tl >= off) cum += t; }
            dtL[(4 * hh + i) * 64 + tl] = dt; acL[(4 * hh + i) * 64 + tl] = cum;
        }
    }
}

__device__ __forceinline__ void conv_mixer(const Args& a, int layer, bf16_t* PROJ, int b, int c, int g, int tid) {
    const int q = tid & 63, tg = tid >> 6, ch = 512 * g + 8 * q;
    const int tb0 = c * 64 + 8 * tg;
    bf16_t* p = PROJ + (size_t)(b * SEQ + tb0) * PW + ch;
    u32x4 rp[10], rb[8];
#pragma unroll
    for (int j = 0; j < 10; ++j) rp[j] = *(const u32x4*)(p + (long)(j - 2) * PW + 2048);
#pragma unroll
    for (int j = 0; j < 8; ++j) rb[j] = *(const u32x4*)(p + (long)j * PW);
    const float* sw = a.in[3] + (size_t)layer * 3 * 1024 + ch;
    float w[3][8];
#pragma unroll
    for (int k = 0; k < 3; ++k) { const f32x4 x = *(const f32x4*)(sw + k * 1024), y = *(const f32x4*)(sw + k * 1024 + 4);
        w[k][0] = x.x; w[k][1] = x.y; w[k][2] = x.z; w[k][3] = x.w; w[k][4] = y.x; w[k][5] = y.y; w[k][6] = y.z; w[k][7] = y.w; }
    asm volatile("" ::: "memory");
    if (tb0 == 0) { rp[0] = (u32x4){0u, 0u, 0u, 0u}; rp[1] = rp[0]; }
    float p0[8], p1[8];
    unpack8(rp[0], p0); unpack8(rp[1], p1);
#pragma unroll
    for (int j = 0; j < 8; ++j) {
        float cur[8], ub[8], o[8];
        unpack8(rp[j + 2], cur); unpack8(rb[j], ub);
#pragma unroll
        for (int e = 0; e < 8; ++e) { o[e] = ub[e] * (w[0][e] * p0[e] + w[1][e] * p1[e] + w[2][e] * cur[e]); p0[e] = p1[e]; p1[e] = cur[e]; }
        *(u32x4*)(p + (long)j * PW) = pack8(o);
    }
}

__device__ __forceinline__ void phase_s1(const Args& a, int layer, LAS unsigned char* L, const int wave) {
    int lane_ = lane_id(); asm volatile("" : "+v"(lane_)); const int lane = lane_, tid0 = wave * 64 + lane;
    bf16_t* PROJ = (bf16_t*)(a.ws + WS_PROJ); const float* DTB = (const float*)(a.ws + WS_DT);
    bf16_t* ST = (bf16_t*)(a.ws + WS_ST); float* CD = (float*)(a.ws + WS_CD);
    const int fr = lane & 15, fq = lane >> 4;
    for (int u = blockIdx.x; u < NB * NCH * 2; u += gridDim.x) {
        const int b = u >> 8, c = (u & 255) >> 1, g = u & 1;
        int tid = tid0; asm volatile("" : "+v"(tid));
        conv_mixer(a, layer, PROJ, b, c, g, tid);
        ssd_stage<true>(a, layer, L, PROJ, DTB, b, c, g, tid);
        __syncthreads();
        const int h = 8 * g + wave;
        const LAS float* dtw = (const LAS float*)(L + L_DT) + wave * 64; const LAS float* acw = (const LAS float*)(L + L_AC) + wave * 64;
        const float aend = acw[63];
        bf16x8 xw[4][2];
#pragma unroll
        for (int ks = 0; ks < 2; ++ks) {
            float wv[8];
#pragma unroll
            for (int e = 0; e < 8; ++e) { const int l = 32 * ks + 8 * fq + e; wv[e] = dtw[l] * __expf(aend - acw[l]); }
#pragma unroll
            for (int pt = 0; pt < 4; ++pt) {
                const u32x4 raw = *(const LAS u32x4*)((const LAS bf16_t*)(L + L_XS) + tr_off(64 * wave + 16 * pt + fr, 32 * ks + 8 * fq));
                float x[8]; unpack8(raw, x);
#pragma unroll
                for (int e = 0; e < 8; ++e) x[e] *= wv[e];
                const u32x4 pk = pack8(x); xw[pt][ks] = __builtin_bit_cast(bf16x8, pk);
            }
        }
        bf16_t* stp = ST + (size_t)((b * NCH + c) * 16 + h) * 8192;
#pragma unroll
        for (int half = 0; half < 2; ++half) {
            f32x4 acc[4][4];
#pragma unroll
            for (int i = 0; i < 4; ++i)
#pragma unroll
                for (int j = 0; j < 4; ++j) acc[i][j] = (f32x4){0.f, 0.f, 0.f, 0.f};
#pragma unroll
            for (int nt = 0; nt < 4; ++nt)
#pragma unroll
                for (int ks = 0; ks < 2; ++ks) {
                    const bf16x8 bf = *(const LAS bf16x8*)((const LAS bf16_t*)(L + L_B) + tr_off(64 * half + 32 * (nt >> 1) + 8 * (fr >> 2) + 4 * (nt & 1) + (fr & 3), 32 * ks + 8 * fq));
#pragma unroll
                    for (int pt = 0; pt < 4; ++pt) acc[nt][pt] = __builtin_amdgcn_mfma_f32_16x16x32_f16(bf, xw[pt][ks], acc[nt][pt], 0, 0, 0);
                }
#pragma unroll
            for (int k2 = 0; k2 < 2; ++k2)
#pragma unroll
                for (int pt = 0; pt < 4; ++pt) { u32x4 w; w.x = cvt_pk_bf16(acc[2 * k2][pt][0], acc[2 * k2][pt][1]); w.y = cvt_pk_bf16(acc[2 * k2][pt][2], acc[2 * k2][pt][3]);
                    w.z = cvt_pk_bf16(acc[2 * k2 + 1][pt][0], acc[2 * k2 + 1][pt][1]); w.w = cvt_pk_bf16(acc[2 * k2 + 1][pt][2], acc[2 * k2 + 1][pt][3]);
                    *(u32x4*)(stp + (16 * pt + fr) * 128 + 64 * half + 32 * k2 + 8 * fq) = w; }
        }
        if (lane == 0) CD[(b * NCH + c) * 16 + h] = __expf(aend);
        __syncthreads();
    }
}

__device__ __forceinline__ void phase_s2(const Args& a, int layer, LAS unsigned char* L, const int wave) {
    int lane_ = lane_id(); asm volatile("" : "+v"(lane_)); const int lane = lane_, tid = wave * 64 + lane;
    if (wave < 4) {
        bf16_t* ST = (bf16_t*)(a.ws + WS_ST); const float* CD = (const float*)(a.ws + WS_CD);
        for (int wi = wave * gridDim.x + blockIdx.x; wi < 1024; wi += 4 * gridDim.x) {
            const int j = wi * 64 + lane, b = j >> 15, within = j & 32767, h = within >> 11;
            bf16_t* p = ST + (size_t)b * NCH * 131072 + (size_t)within * 4;
            const float* cd = CD + b * NCH * 16 + h;
            float H0 = 0.f, H1 = 0.f, H2 = 0.f, H3 = 0.f;
            for (int c0 = 0; c0 < NCH; c0 += 16) {
                u32x2 sv[16]; float d[16];
#pragma unroll
                for (int i = 0; i < 16; ++i) { sv[i] = *(const u32x2*)(p + (size_t)(c0 + i) * 131072); d[i] = cd[(c0 + i) * 16]; }
                asm volatile("" ::: "memory");
#pragma unroll
                for (int i = 0; i < 16; ++i) {
                    u32x2 o; o.x = cvt_pk_bf16(H0, H1); o.y = cvt_pk_bf16(H2, H3);
                    *(u32x2*)(p + (size_t)(c0 + i) * 131072) = o;
                    H0 = H0 * d[i] + bf_lo(sv[i].x); H1 = H1 * d[i] + bf_hi(sv[i].x); H2 = H2 * d[i] + bf_lo(sv[i].y); H3 = H3 * d[i] + bf_hi(sv[i].y);
                }
            }
        }
    } else if (layer + 1 < DEPTH) {
        convert_layer(a, layer + 1, a.ws + WS_WB + (size_t)((layer + 1) & 1) * WB_BYTES, (LAS float*)(L + wave * 16384), (wave - 4) * gridDim.x + blockIdx.x, 4 * gridDim.x, lane, (gridDim.x == 256) ? CONV_SPLIT : 0);
    }
}

__device__ __forceinline__ void phase_s3(const Args& a, int layer, LAS unsigned char* L, const int wave) {
    int lane_ = lane_id(); asm volatile("" : "+v"(lane_)); const int lane = lane_, tid0 = wave * 64 + lane;
    bf16_t* PROJ = (bf16_t*)(a.ws + WS_PROJ); const float* DTB = (const float*)(a.ws + WS_DT);
    const bf16_t* ST = (const bf16_t*)(a.ws + WS_ST);
    for (int u = blockIdx.x; u < NB * NCH * 2; u += gridDim.x) {
        const int b = u >> 8, c = (u & 255) >> 1, g = u & 1;
        int tid = tid0; asm volatile("" : "+v"(tid));
        const int h = 8 * g + wave, rowbase = b * SEQ + c * 64;
        ssd_stage<false>(a, layer, L, PROJ, DTB, b, c, g, tid);
        int ln2 = lane; asm volatile("" : "+v"(ln2));
        const int fr = ln2 & 15, fq = ln2 >> 4, frl = fr, fql = fq;
        const bf16_t* prevp = ST + (size_t)((b * NCH + c) * 16 + h) * 8192 + (8 * (frl >> 2) + (frl & 3)) * 128 + 8 * fql;
        bf16x8 pf[4][4];
#pragma unroll
        for (int ks = 0; ks < 4; ++ks)
#pragma unroll
            for (int pt = 0; pt < 4; ++pt) pf[ks][pt] = *(const bf16x8*)(prevp + (32 * (pt >> 1) + 4 * (pt & 1)) * 128 + 32 * ks);
        asm volatile("" ::: "memory");
        __syncthreads();
        const LAS float* dtw = (const LAS float*)(L + L_DT) + wave * 64; const LAS float* acw = (const LAS float*)(L + L_AC) + wave * 64;
        const LAS bf16_t* xsT = (const LAS bf16_t*)(L + L_XS);
        const LAS bf16_t* Bl = (const LAS bf16_t*)(L + L_B); const LAS bf16_t* Cl = (const LAS bf16_t*)(L + L_C);
        LAS bf16_t* Mw = (LAS bf16_t*)(L + L_M) + wave * 1152;
        float al[4];
#pragma unroll
        for (int lt = 0; lt < 4; ++lt) al[lt] = acw[16 * lt + fr];
        f32x4 acc[4][4];
#pragma unroll
        for (int i = 0; i < 4; ++i)
#pragma unroll
            for (int j = 0; j < 4; ++j) acc[i][j] = (f32x4){0.f, 0.f, 0.f, 0.f};
        u32x4 zr[4][2];
#pragma unroll
        for (int lt = 0; lt < 4; ++lt)
#pragma unroll
            for (int k2 = 0; k2 < 2; ++k2) zr[lt][k2] = *(const u32x4*)(PROJ + (size_t)(rowbase + 16 * lt + fr) * PW + 1024 + 64 * h + 32 * k2 + 8 * fq);
        asm volatile("" ::: "memory");
#pragma unroll
        for (int lt = 0; lt < 4; ++lt) {
            bf16x8 cf[4];
#pragma unroll
            for (int ks = 0; ks < 4; ++ks) cf[ks] = *(const LAS bf16x8*)(Cl + (16 * lt + fr) * 136 + 32 * ks + 8 * fq);
#pragma unroll
            for (int st = 0; st < 4; ++st) {
                f32x4 m = (f32x4){0.f, 0.f, 0.f, 0.f};
                if (st <= lt) {
                    f32x4 sc = (f32x4){0.f, 0.f, 0.f, 0.f};
#pragma unroll
                    for (int ks = 0; ks < 4; ++ks) { const bf16x8 bfr = *(const LAS bf16x8*)(Bl + (16 * st + fr) * 136 + 32 * ks + 8 * fq); sc = __builtin_amdgcn_mfma_f32_16x16x32_f16(bfr, cf[ks], sc, 0, 0, 0); }
#pragma unroll
                    for (int r = 0; r < 4; ++r) { const int s = 16 * st + 4 * fq + r, l = 16 * lt + fr; const float v = sc[r] * __expf(al[lt] - acw[s]) * dtw[s]; m[r] = (s <= l) ? v : 0.f; }
                }
                u32x2 w; w.x = cvt_pk_bf16(m[0], m[1]); w.y = cvt_pk_bf16(m[2], m[3]);
                *(LAS u32x2*)(Mw + fr * 72 + 16 * st + 4 * fq) = w;
            }
            asm volatile("s_waitcnt lgkmcnt(0)" ::: "memory");
#pragma unroll
            for (int ks = 0; ks < 2; ++ks) { const bf16x8 mf = *(const LAS bf16x8*)(Mw + fr * 72 + 32 * ks + 8 * fq);
#pragma unroll
                for (int pt = 0; pt < 4; ++pt) { const bf16x8 xf = *(const LAS bf16x8*)(xsT + tr_off(64 * wave + 32 * (pt >> 1) + 8 * (fr >> 2) + 4 * (pt & 1) + (fr & 3), 32 * ks + 8 * fq)); acc[lt][pt] = __builtin_amdgcn_mfma_f32_16x16x32_f16(xf, mf, acc[lt][pt], 0, 0, 0); } }
            asm volatile("s_waitcnt lgkmcnt(0)" ::: "memory");
        }
#pragma unroll
        for (int lt = 0; lt < 4; ++lt) {
            f32x4 a2[4];
#pragma unroll
            for (int pt = 0; pt < 4; ++pt) a2[pt] = (f32x4){0.f, 0.f, 0.f, 0.f};
#pragma unroll
            for (int ks = 0; ks < 4; ++ks) { const bf16x8 cf = *(const LAS bf16x8*)(Cl + (16 * lt + fr) * 136 + 32 * ks + 8 * fq);
#pragma unroll
                for (int pt = 0; pt < 4; ++pt) a2[pt] = __builtin_amdgcn_mfma_f32_16x16x32_f16(pf[ks][pt], cf, a2[pt], 0, 0, 0); }
            const float e = __expf(al[lt]);
#pragma unroll
            for (int pt = 0; pt < 4; ++pt) acc[lt][pt] = acc[lt][pt] + a2[pt] * e;
        }
        const float dsk = a.in[8][layer * 16 + h];
        LAS float* red = (LAS float*)(L + L_RED);
#pragma unroll
        for (int lt = 0; lt < 4; ++lt) {
            const int l = 16 * lt + fr; float ss = 0.f;
#pragma unroll
            for (int k2 = 0; k2 < 2; ++k2) {
                float zz[8]; unpack8(zr[lt][k2], zz);
#pragma unroll
                for (int o2 = 0; o2 < 2; ++o2)
#pragma unroll
                    for (int r = 0; r < 4; ++r) { const int pt = 2 * k2 + o2, p = 32 * k2 + 8 * fq + 4 * o2 + r;
                        const float xs = bf2f(xsT[tr_off(64 * wave + p, l)]); const float y = acc[lt][pt][r] + dsk * xs; const float gt = y * silu_f(zz[4 * o2 + r]); acc[lt][pt][r] = gt; ss += gt * gt; }
            }
            ss += __shfl_xor(ss, 16); ss += __shfl_xor(ss, 32);
            if (fq == 0) red[wave * 64 + l] = ss;
        }
        __syncthreads();
        const float* nw = a.in[9] + (size_t)layer * 1024 + 64 * h;
#pragma unroll
        for (int lt = 0; lt < 4; ++lt) {
            const int l = 16 * lt + fr; float tot = 0.f;
#pragma unroll
            for (int w8 = 0; w8 < 8; ++w8) tot += red[w8 * 64 + l];
            const float rs = rsqrtf(tot * (1.f / 512.f) + EPS);
#pragma unroll
            for (int k2 = 0; k2 < 2; ++k2) {
                const int pb = 32 * k2 + 8 * fq; const f32x4 n0 = *(const f32x4*)(nw + pb), n1 = *(const f32x4*)(nw + pb + 4);
                const f32x4 o0 = acc[lt][2 * k2] * rs * n0, o1 = acc[lt][2 * k2 + 1] * rs * n1;
                u32x4 w; w.x = cvt_pk_bf16(o0[0], o0[1]); w.y = cvt_pk_bf16(o0[2], o0[3]); w.z = cvt_pk_bf16(o1[0], o1[1]); w.w = cvt_pk_bf16(o1[2], o1[3]);
                *(u32x4*)(PROJ + (size_t)(rowbase + l) * PW + 1024 + 64 * h + pb) = w;
            }
        }
        __syncthreads();
    }
}

#define FUSE_FINAL (N_LAUNCH_MODE == 1)
#ifndef N_LAUNCH_MODE
#define N_LAUNCH_MODE 1
#endif
constexpr int NPHASE = 2 + 7 * DEPTH;

__global__ void __launch_bounds__(512, 2) trunk_fwd(Args args) {
    extern __shared__ __attribute__((aligned(16))) unsigned char lds_raw[];
    LAS unsigned char* L = (LAS unsigned char*)lds_raw;
    const int wave = __builtin_amdgcn_readfirstlane(threadIdx.x >> 6);
#define lane lane_id()
#define tid (wave * 64 + lane_id())
    const int G = gridDim.x;
    const int lo = args.ph_lo, hi = args.ph_hi;
    unsigned char* ws = args.ws;
    bf16_t* PROJ = (bf16_t*)(ws + WS_PROJ); bf16_t* HID = PROJ; bf16_t* XB = (bf16_t*)(ws + WS_XB);
    float* DTB = (float*)(ws + WS_DT); float* SSQ = (float*)(ws + WS_SSQ);
    float* X = args.out;
#define IN(k) (lo <= (k) && (k) < hi)
    volatile LAS unsigned* MISC = (volatile LAS unsigned*)(L + L_MISC);
    if (tid < 4) MISC[tid] = 0u;
    __syncthreads();
    XcdBarrier bar; bar.bar = (unsigned*)(ws + WS_BAR); bar.x = 0; bar.st = MISC;
    if (hi - lo > 1) bar = xcd_barrier_post((unsigned*)(ws + WS_BAR), MISC);
#define SEAM(k) do { if (IN(k) && IN((k) + 1)) xcd_barrier(bar); } while (0)
    if (IN(0)) {
        const int gw = blockIdx.x * 8 + wave, NGW = G * 8;
        convert_layer(args, 0, ws + WS_WB, (LAS float*)(L + wave * 16384), gw, NGW, lane);
        const float* x = args.in[0];
        for (int m = gw; m < M; m += 2 * NGW) {
            const int m2 = (m + NGW < M) ? m + NGW : m;
            const f32x4* xr = (const f32x4*)(x + (size_t)m * DM) + lane; const f32x4* xr2 = (const f32x4*)(x + (size_t)m2 * DM) + lane;
            float s = 0.f, s2 = 0.f; f32x4 v[4], v2[4];
#pragma unroll
            for (int j = 0; j < 4; ++j) { v[j] = xr[64 * j]; v2[j] = xr2[64 * j]; }
#pragma unroll
            for (int j = 0; j < 4; ++j) { s += (v[j].x * v[j].x + v[j].y * v[j].y) + (v[j].z * v[j].z + v[j].w * v[j].w); s2 += (v2[j].x * v2[j].x + v2[j].y * v2[j].y) + (v2[j].z * v2[j].z + v2[j].w * v2[j].w); }
            s = wave_sum(s); s2 = wave_sum(s2);
            u32x2* o = (u32x2*)(XB + (size_t)m * DM) + lane; u32x2* o2 = (u32x2*)(XB + (size_t)m2 * DM) + lane;
#pragma unroll
            for (int j = 0; j < 4; ++j) { u32x2 w; w.x = cvt_pk_bf16(v[j].x, v[j].y); w.y = cvt_pk_bf16(v[j].z, v[j].w); o[64 * j] = w;
                                          u32x2 w2; w2.x = cvt_pk_bf16(v2[j].x, v2[j].y); w2.y = cvt_pk_bf16(v2[j].z, v2[j].w); o2[64 * j] = w2; }
            if (lane < 16) { SSQ[(size_t)m * 16 + lane] = (lane == 0) ? s : 0.f; SSQ[(size_t)m2 * 16 + lane] = (lane == 0) ? s2 : 0.f; }
        }
    }
    SEAM(0);
    for (int layer = 0; layer < DEPTH; ++layer) {
        const int pb = 1 + 7 * layer;
        unsigned char* wb = ws + WS_WB + (size_t)(layer & 1) * WB_BYTES;
        if (IN(pb + 0)) {
            pg8::Gemm g{XB, (const bf16_t*)(wb + WB_IN), M, INP, DM, DM}; pg8::StaticOrder S; S.init(M, INP, G, (int)blockIdx.x);
            EpiInProj E{PROJ, DTB, SSQ};
            pg8::gemm_phase<EpiInProj, true>(L, g, S, E, wave);
            if (G == 256 && blockIdx.x >= 192 && layer + 1 < DEPTH)
                convert_layer(args, layer + 1, ws + WS_WB + (size_t)((layer + 1) & 1) * WB_BYTES, (LAS float*)(L + wave * 16384), wave * 64 + ((int)blockIdx.x - 192), 512, lane_id(), 0, CONV_SPLIT);
        }
        SEAM(pb + 0);
        if (IN(pb + 1)) phase_s1(args, layer, L, wave);
        SEAM(pb + 1);
        if (IN(pb + 2)) phase_s2(args, layer, L, wave);
        SEAM(pb + 2);
        if (IN(pb + 3)) phase_s3(args, layer, L, wave);
        SEAM(pb + 3);
        if (IN(pb + 4)) {
            pg8::Gemm g{PROJ, (const bf16_t*)(wb + WB_OUT), M, DM, MIXW, PW}; pg8::StaticOrder S; S.init(M, DM, G, (int)blockIdx.x);
            EpiResid E{XB, SSQ};
            pg8::gemm_phase<EpiResid, true>(L, g, S, E, wave);
        }
        SEAM(pb + 4);
        if (IN(pb + 5)) {
            pg8::Gemm g{XB, (const bf16_t*)(wb + WB_UP), M, FF, DM, DM}; pg8::StaticOrder S; S.init(M, FF, G, (int)blockIdx.x);
            EpiUp E{HID, SSQ};
            pg8::gemm_phase<EpiUp, true>(L, g, S, E, wave);
        }
        SEAM(pb + 5);
        if (IN(pb + 6)) {
            pg8::Gemm g{HID, (const bf16_t*)(wb + WB_DN), M, DM, FF, FF}; pg8::StaticOrder S; S.init(M, DM, G, (int)blockIdx.x);
            if (FUSE_FINAL && layer == DEPTH - 1 && G == 256) { EpiFinal E{XB, X, SSQ, (unsigned*)(ws + WS_BAR) + 4096, args.in[14]}; pg8::gemm_phase<EpiFinal, true>(L, g, S, E, wave); }
            else { EpiResid E{XB, SSQ}; pg8::gemm_phase<EpiResid, true>(L, g, S, E, wave); }
        }
        if (!(FUSE_FINAL && layer == DEPTH - 1 && G == 256)) SEAM(pb + 6);
    }
    if (IN(NPHASE - 1) && !(FUSE_FINAL && G == 256)) {
        const int gw = blockIdx.x * 8 + wave, NGW = G * 8;
        const f32x4* fw = (const f32x4*)args.in[14];
        for (int m = gw; m < M; m += 2 * NGW) {
            const int m2 = (m + NGW < M) ? m + NGW : m;
            const u32x4* xr = (const u32x4*)(XB + (size_t)m * DM); const u32x4* xr2 = (const u32x4*)(XB + (size_t)m2 * DM);
            u32x4 v[2], v2[2];
#pragma unroll
            for (int j = 0; j < 2; ++j) { v[j] = xr[lane + 64 * j]; v2[j] = xr2[lane + 64 * j]; }
            const float rs = row_rstd(SSQ, m), rs2 = row_rstd(SSQ, m2);
            f32x4* o = (f32x4*)(X + (size_t)m * DM); f32x4* o2 = (f32x4*)(X + (size_t)m2 * DM);
#pragma unroll
            for (int j = 0; j < 2; ++j) {
                const int e = 2 * (lane + 64 * j); const f32x4 w0 = fw[e], w1 = fw[e + 1];
                float a[8], b[8]; unpack8(v[j], a); unpack8(v2[j], b);
                o[e] = (f32x4){a[0], a[1], a[2], a[3]} * rs * w0; o[e + 1] = (f32x4){a[4], a[5], a[6], a[7]} * rs * w1;
                o2[e] = (f32x4){b[0], b[1], b[2], b[3]} * rs2 * w0; o2[e + 1] = (f32x4){b[4], b[5], b[6], b[7]} * rs2 * w1;
            }
        }
    }
#undef IN
#undef SEAM
#undef lane
#undef tid
}

extern "C" void kernel_launch(void* const* d_in, const int* in_sizes, int n_in, void* d_out, int out_size, void* d_ws, size_t ws_size, hipStream_t stream) {
    static int grid = 0;
    if (grid == 0) {
        if (n_in != 15 || out_size != M * DM || ws_size < WS_END) { fprintf(stderr, "kernel_launch: unexpected shapes (n_in %d out %d ws %zu)\n", n_in, out_size, ws_size); grid = -1; return; }
        int dev = 0, cus = 0, per_cu = 0;
        hipGetDevice(&dev); hipDeviceGetAttribute(&cus, hipDeviceAttributeMultiprocessorCount, dev);
        if (hipFuncSetAttribute((const void*)trunk_fwd, hipFuncAttributeMaxDynamicSharedMemorySize, LDS_BYTES) != hipSuccess) { fprintf(stderr, "kernel_launch: hipFuncSetAttribute failed\n"); grid = -1; return; }
        if (hipOccupancyMaxActiveBlocksPerMultiprocessor(&per_cu, (const void*)trunk_fwd, 512, LDS_BYTES) != hipSuccess || per_cu < 1) { fprintf(stderr, "kernel_launch: occupancy query says %d\n", per_cu); per_cu = 1; }
        (void)hipGetLastError();
        grid = cus;
    }
    if (grid < 0) return;
    if (hipMemsetAsync((char*)d_ws + WS_BAR, 0, BAR_BYTES, stream) != hipSuccess) { fprintf(stderr, "kernel_launch: memset failed\n"); return; }
    Args a{};
    for (int i = 0; i < 15; ++i) a.in[i] = (const float*)d_in[i];
    a.out = (float*)d_out; a.ws = (unsigned char*)d_ws;
#if N_LAUNCH_MODE == 1
    a.ph_lo = 0; a.ph_hi = NPHASE;
    void* kargs[] = {&a};
    hipError_t e = hipLaunchCooperativeKernel((const void*)trunk_fwd, dim3(grid), dim3(512), kargs, LDS_BYTES, stream);
    if (e != hipSuccess) fprintf(stderr, "cooperative launch failed: %s (grid %d)\n", hipGetErrorString(e), grid);
#else
    for (int p = 0; p < NPHASE; ++p) { a.ph_lo = p; a.ph_hi = p + 1; hipLaunchKernelGGL(trunk_fwd, dim3(grid), dim3(512), LDS_BYTES, stream, a); }
#endif
}
```

```cpp
#include <hip/hip_runtime.h>
#include <hip/hip_cooperative_groups.h>
#include <cstdio>
#include <cstdint>
namespace cg = cooperative_groups;

#define LAS __attribute__((address_space(3)))
typedef unsigned short bf16_t;
typedef _Float16 bf16x8 __attribute__((ext_vector_type(8)));
typedef _Float16 h16x2 __attribute__((ext_vector_type(2)));
typedef float f32x4 __attribute__((ext_vector_type(4)));
typedef float f32x2 __attribute__((ext_vector_type(2)));
typedef unsigned u32x4 __attribute__((ext_vector_type(4)));
typedef unsigned u32x2 __attribute__((ext_vector_type(2)));

constexpr int DM = 1024, NB = 2, SEQ = 8192, DEPTH = 4, M = NB * SEQ;
constexpr int NCH = SEQ / 64;
constexpr int INC = 5648, INP = 5888;
constexpr int PW = 4608;
constexpr int C_XBC = 3072;
constexpr int FF = 4096, MIXW = 2048;
constexpr float EPS = 1e-5f;

constexpr size_t MiB = 1u << 20;
constexpr size_t WS_WB = 0, WB_BYTES = 32 * MiB;
constexpr size_t WB_IN = 0, WB_OUT = 12 * MiB, WB_UP = 16 * MiB, WB_DN = 24 * MiB;
constexpr size_t WS_PROJ = 64 * MiB;
constexpr size_t WS_XB = 240 * MiB;
constexpr size_t WS_ST = 272 * MiB;
constexpr size_t WS_DT = 336 * MiB;
constexpr size_t WS_SSQ = 337 * MiB;
constexpr size_t WS_CD = 338 * MiB;
constexpr size_t WS_BAR = 338 * MiB + 65536;
constexpr size_t BAR_BYTES = 32768;
constexpr size_t WS_END = 339 * MiB;

constexpr int LDS_BYTES = 147456 + 256;
constexpr int L_SSQ = 131072, L_MISC = 147456;

__device__ __forceinline__ unsigned cvt_pk_bf16(float lo, float hi) { h16x2 v; v.x = (_Float16)__builtin_amdgcn_fmed3f(lo, -65504.f, 65504.f); v.y = (_Float16)__builtin_amdgcn_fmed3f(hi, -65504.f, 65504.f); return __builtin_bit_cast(unsigned, v); }
__device__ __forceinline__ float bf_lo(unsigned w) { return (float)__builtin_bit_cast(h16x2, w).x; }
__device__ __forceinline__ float bf_hi(unsigned w) { return (float)__builtin_bit_cast(h16x2, w).y; }
__device__ __forceinline__ float bf2f(bf16_t h) { return (float)__builtin_bit_cast(_Float16, h); }
__device__ __forceinline__ void unpack8(const u32x4 r, float (&o)[8]) { o[0] = bf_lo(r.x); o[1] = bf_hi(r.x); o[2] = bf_lo(r.y); o[3] = bf_hi(r.y); o[4] = bf_lo(r.z); o[5] = bf_hi(r.z); o[6] = bf_lo(r.w); o[7] = bf_hi(r.w); }
__device__ __forceinline__ u32x4 pack8(const float (&o)[8]) { u32x4 w; w.x = cvt_pk_bf16(o[0], o[1]); w.y = cvt_pk_bf16(o[2], o[3]); w.z = cvt_pk_bf16(o[4], o[5]); w.w = cvt_pk_bf16(o[6], o[7]); return w; }
__device__ __forceinline__ int lane_id() { int l; asm volatile("v_mbcnt_lo_u32_b32 %0, -1, 0\n\tv_mbcnt_hi_u32_b32 %0, -1, %0" : "=v"(l)); return l; }
__device__ __forceinline__ float silu_f(float x) { return x * __builtin_amdgcn_rcpf(1.f + __expf(-x)); }

__device__ __forceinline__ float row_rstd(const float* ssqp, int row) {
    const f32x4* p = (const f32x4*)(ssqp + (size_t)row * 16);
    const f32x4 a = p[0], b = p[1], c = p[2], d = p[3];
    const float s = (((a.x + a.y) + (a.z + a.w)) + ((b.x + b.y) + (b.z + b.w))) + (((c.x + c.y) + (c.z + c.w)) + ((d.x + d.y) + (d.z + d.w)));
    return rsqrtf(s * (1.f / 1024.f) + EPS);
}

__device__ __forceinline__ float row_rstd_lds(LAS unsigned char* lds, int rl) {
    const LAS f32x4* p = (const LAS f32x4*)(lds + 131072 + rl * 64);
    const f32x4 a = p[0], b = p[1], c = p[2], d = p[3];
    const float s = (((a.x + a.y) + (a.z + a.w)) + ((b.x + b.y) + (b.z + b.w))) + (((c.x + c.y) + (c.z + c.w)) + ((d.x + d.y) + (d.z + d.w)));
    return rsqrtf(s * (1.f / 1024.f) + EPS);
}

namespace pg8 {
constexpr int BM = 256, BK = 64, HALF = 128, HTB = HALF * BK * 2, STAGE_BYTES = 8 * HTB, NXCD = 8, WGM = 8;
__host__ __device__ __forceinline__ int lds_byte(int r, int c) { const int st = (r >> 4) * 2 + (c >> 5), rr = r & 15, cc = c & 31, ob = rr * 64 + cc * 2; return st * 1024 + (ob ^ (((ob >> 9) & 1) << 5)); }
__host__ __device__ __forceinline__ void stage_rc(int b, int& R, int& C) { const int st = b / 1024, sb = b % 1024, swz = sb ^ (((sb >> 9) & 1) << 5); R = (st >> 1) * 16 + swz / 64; C = (st & 1) * 32 + (swz % 64) / 2; }
__host__ __device__ __forceinline__ int perm32(int rho) { const int n = rho >> 4, i = rho & 15; return 8 * (i >> 2) + 4 * n + (i & 3); }
struct Unit { int pm, pn; };
struct Gemm { const bf16_t* A; const bf16_t* Bt; int M, N, K, lda; };
struct StaticOrder {
    int nM, nN, nwg, G, c;
    __host__ __device__ void init(int M_, int N_, int G_, int c_) { nM = M_ / BM; nN = N_ / BM; nwg = nM * nN; G = G_; c = c_; }
    __host__ __device__ bool next(int i, Unit& u) const {
        const long L = (long)i * G + c; if (L >= nwg) return false;
        int wgid = (int)L; { const int q = nwg / NXCD, r = nwg % NXCD, xcd = wgid % NXCD, off = wgid / NXCD; wgid = (xcd < r ? xcd * (q + 1) : r * (q + 1) + (xcd - r) * q) + off; }
        const int nig = WGM * nN, gid = wgid / nig, fm = gid * WGM, gsz = (nM - fm) < WGM ? (nM - fm) : WGM;
        u.pm = fm + ((wgid % nig) % gsz); u.pn = (wgid % nig) / gsz; return true;
    }
};
template <class Epi, bool ALIGN_EPI>
__device__ __forceinline__ void gemm_phase(LAS unsigned char* lds, const Gemm g, const StaticOrder& S, const Epi& E, const int wave_) {
    int lane_ = lane_id(); asm volatile("" : "+v"(lane_));
    int wv_ = wave_; asm volatile("" : "+s"(wv_));
    const int wid = wv_, lane = lane_, tid = wid * 64 + lane, wr = wid >> 2, wc = wid & 3, fr = lane & 15, fq = lane >> 4;
    const int K = g.K, nt = K / BK, lda = g.lda;
    unsigned voffA[2], voffB[2];
#pragma unroll
    for (int i = 0; i < 2; ++i) { int R, C; stage_rc(tid * 16 + i * 8192, R, C); const int Rb = (R & ~31) + perm32(R & 31);
        voffA[i] = (unsigned)(R * lda + C) * 2u; voffB[i] = (unsigned)(Rb * K + C) * 2u; }
    const size_t kstep = (size_t)(BK * 2);
    const size_t hstepA = (size_t)HALF * lda * 2, hstepB = (size_t)HALF * K * 2;
    const size_t tstepA = 2 * hstepA, tstepB = 2 * hstepB;
    const unsigned ldsw = (unsigned)wid * 1024u;
    const int aoff = lds_byte(wr * 64 + fr, fq * 8), boff = lds_byte(wc * 32 + fr, fq * 8);
#define PG8_SA(b, h) (((b) * 2 + (h)) * HTB)
#define PG8_SB(b, h) ((4 + (b) * 2 + (h)) * HTB)
#define PG8_STAGE(bufoff, gbase, voff) do { _Pragma("unroll") for (int _i = 0; _i < 2; ++_i) \
        __builtin_amdgcn_global_load_lds((const unsigned*)((const char*)(gbase) + (voff)[_i]), (LAS unsigned*)(lds + (bufoff) + ldsw + _i * 8192), 16, 0, 0); } while (0)
#define PG8_LDA(dst, b, h) do { _Pragma("unroll") for (int m = 0; m < 4; ++m) _Pragma("unroll") for (int k = 0; k < 2; ++k) dst[m][k] = *(const LAS bf16x8*)(lds + PG8_SA(b, h) + aoff + m * 2048 + k * 1024); } while (0)
#define PG8_LDB(dst, b, h) do { _Pragma("unroll") for (int n = 0; n < 2; ++n) _Pragma("unroll") for (int k = 0; k < 2; ++k) dst[n][k] = *(const LAS bf16x8*)(lds + PG8_SB(b, h) + boff + n * 2048 + k * 1024); } while (0)
#define PG8_MMA(ai, bj, At, Bt) do { __builtin_amdgcn_s_setprio(1); _Pragma("unroll") for (int k = 0; k < 2; ++k) _Pragma("unroll") for (int m = 0; m < 4; ++m) _Pragma("unroll") for (int n = 0; n < 2; ++n) \
        acc[ai][bj][m][n] = __builtin_amdgcn_mfma_f32_16x16x32_f16(Bt[n][k], At[m][k], acc[ai][bj][m][n], 0, 0, 0); __builtin_amdgcn_s_setprio(0); } while (0)
#define PG8_WAIT_V(n) asm volatile("s_waitcnt vmcnt(" #n ")" ::: "memory")
#define PG8_WAIT_L(n) asm volatile("s_waitcnt lgkmcnt(" #n ")" ::: "memory")
#define PG8_BAR __builtin_amdgcn_s_barrier()
#define PG8_SCHED __builtin_amdgcn_sched_barrier(0)
#define PG8_SSQ_HOOK(U) do { const unsigned hook_lo = (unsigned)lane_id() * 16u; _Pragma("unroll") for (int _i = 0; _i < 2; ++_i) \
        __builtin_amdgcn_global_load_lds((const unsigned*)((const char*)E.ssqp + (size_t)((U).pm * BM + 32 * wid + 16 * _i) * 64 + hook_lo), (LAS unsigned*)(lds + L_SSQ + (32 * wid + 16 * _i) * 64), 16, 0, 0); } while (0)
    Unit cur, nxt; int ui = 0;
    if (!S.next(0, cur)) return;
    if constexpr (Epi::PREFETCH_SSQ) PG8_SSQ_HOOK(cur);
    f32x4 acc[2][2][4][2];
#pragma unroll
    for (int a = 0; a < 2; ++a)
#pragma unroll
        for (int b = 0; b < 2; ++b)
#pragma unroll
            for (int m = 0; m < 4; ++m)
#pragma unroll
                for (int n = 0; n < 2; ++n) acc[a][b][m][n] = (f32x4){0.f, 0.f, 0.f, 0.f};
    bf16x8 At[4][2], B0[2][2], B1[2][2];
    const char* cA = (const char*)g.A + (size_t)cur.pm * tstepA; const char* cB = (const char*)g.Bt + (size_t)cur.pn * tstepB;
    PG8_STAGE(PG8_SB(0, 0), cB, voffB); PG8_STAGE(PG8_SB(0, 1), cB + hstepB, voffB); PG8_STAGE(PG8_SA(0, 0), cA, voffA); PG8_STAGE(PG8_SA(0, 1), cA + hstepA, voffA);
    if (wr == 1) PG8_BAR;
    PG8_WAIT_V(2); PG8_BAR;
    PG8_STAGE(PG8_SB(1, 0), cB + kstep, voffB); PG8_STAGE(PG8_SA(1, 0), cA + kstep, voffA); PG8_STAGE(PG8_SB(1, 1), cB + hstepB + kstep, voffB);
    PG8_WAIT_V(6); PG8_BAR;
    for (;;) {
        const bool has_next = S.next(ui + 1, nxt);
        const char* nA = has_next ? (const char*)g.A + (size_t)nxt.pm * tstepA : cA; const char* nB = has_next ? (const char*)g.Bt + (size_t)nxt.pn * tstepB : cB;
        for (int t = 0; t < nt; t += 2) {
            const bool last = (t == nt - 2);
            const char* a1 = cA + (size_t)(t + 1) * kstep;
            const char* a2 = last ? nA : cA + (size_t)(t + 2) * kstep; const char* b2 = last ? nB : cB + (size_t)(t + 2) * kstep;
            const char* a3 = a2 + kstep; const char* b3 = b2 + kstep;
            PG8_LDB(B0, 0, 0); PG8_LDB(B1, 0, 1); PG8_SCHED; PG8_LDA(At, 0, 0); PG8_STAGE(PG8_SA(1, 1), a1 + hstepA, voffA);
            PG8_WAIT_V(8); PG8_WAIT_L(0); PG8_BAR; PG8_MMA(0, 0, At, B0); PG8_MMA(0, 1, At, B1); PG8_BAR; PG8_SCHED;
            PG8_LDA(At, 0, 1); PG8_STAGE(PG8_SB(0, 0), b2, voffB); PG8_STAGE(PG8_SB(0, 1), b2 + hstepB, voffB); PG8_STAGE(PG8_SA(0, 0), a2, voffA);
            PG8_WAIT_V(8); PG8_WAIT_L(0); PG8_BAR; PG8_MMA(1, 0, At, B0); PG8_MMA(1, 1, At, B1); PG8_BAR; PG8_SCHED;
            PG8_LDB(B0, 1, 0); PG8_LDB(B1, 1, 1); PG8_SCHED; PG8_LDA(At, 1, 0); PG8_STAGE(PG8_SA(0, 1), a2 + hstepA, voffA);
            PG8_WAIT_V(8); PG8_WAIT_L(0); PG8_BAR; PG8_MMA(0, 0, At, B0); PG8_MMA(0, 1, At, B1); PG8_BAR; PG8_SCHED;
            PG8_LDA(At, 1, 1); PG8_STAGE(PG8_SB(1, 0), b3, voffB); PG8_STAGE(PG8_SB(1, 1), b3 + hstepB, voffB); PG8_STAGE(PG8_SA(1, 0), a3, voffA);
            PG8_WAIT_V(8); PG8_WAIT_L(0); PG8_BAR; PG8_MMA(1, 0, At, B0); PG8_MMA(1, 1, At, B1); PG8_BAR; PG8_SCHED;
        }
        if constexpr (ALIGN_EPI) { if (wr == 0) PG8_BAR; }
        { const int l2 = lane_id(); E(acc, cur, wr, wc, l2 & 15, l2 >> 4, lds); }
        if (!has_next) break;
#pragma unroll
        for (int a = 0; a < 2; ++a)
#pragma unroll
            for (int b = 0; b < 2; ++b)
#pragma unroll
                for (int m = 0; m < 4; ++m)
#pragma unroll
                    for (int n = 0; n < 2; ++n) acc[a][b][m][n] = (f32x4){0.f, 0.f, 0.f, 0.f};
        cur = nxt; cA = nA; cB = nB; ++ui;
        if constexpr (Epi::PREFETCH_SSQ) { PG8_BAR; PG8_SSQ_HOOK(cur); }
        if constexpr (ALIGN_EPI) { if (wr == 1) PG8_BAR; }
    }
    PG8_WAIT_V(0);
    if constexpr (!ALIGN_EPI) { if (wr == 0) PG8_BAR; }
    PG8_BAR;
#undef PG8_SSQ_HOOK
#undef PG8_SA
#undef PG8_SB
#undef PG8_STAGE
#undef PG8_LDA
#undef PG8_LDB
#undef PG8_MMA
#undef PG8_WAIT_V
#undef PG8_WAIT_L
#undef PG8_BAR
#undef PG8_SCHED
}
}

struct EpiInProj {
    static constexpr bool PREFETCH_SSQ = true;
    bf16_t* P; float* DT; const float* ssqp;
    __device__ __forceinline__ void operator()(f32x4 (&acc)[2][2][4][2], const pg8::Unit& u, int wr, int wc, int fr, int fq, LAS unsigned char* lds) const {
        const int pn = u.pn, row0 = u.pm * 256 + wr * 64 + fr, cw0 = wc * 32 + 8 * fq;
#pragma unroll
        for (int ai = 0; ai < 2; ++ai)
#pragma unroll
            for (int m = 0; m < 4; ++m) {
                const int row = row0 + ai * 128 + m * 16; const float rs = row_rstd_lds(lds, ai * 128 + wr * 64 + m * 16 + fr);
                if (pn >= 8 && pn < 16) {
                    const float r2 = rs * rs;
                    const f32x4 v0 = acc[ai][0][m][0] * acc[ai][1][m][0] * r2, v1 = acc[ai][0][m][1] * acc[ai][1][m][1] * r2;
                    u32x4 w; w.x = cvt_pk_bf16(v0[0], v0[1]); w.y = cvt_pk_bf16(v0[2], v0[3]); w.z = cvt_pk_bf16(v1[0], v1[1]); w.w = cvt_pk_bf16(v1[2], v1[3]);
                    *(u32x4*)(P + (size_t)row * PW + 2048 + 128 * (pn - 8) + cw0) = w;
                } else {
#pragma unroll
                    for (int bj = 0; bj < 2; ++bj) {
                        const int gcol = pn * 256 + bj * 128 + cw0; const f32x4 v0 = acc[ai][bj][m][0] * rs, v1 = acc[ai][bj][m][1] * rs;
                        if (pn < 22) { u32x4 w; w.x = cvt_pk_bf16(v0[0], v0[1]); w.y = cvt_pk_bf16(v0[2], v0[3]); w.z = cvt_pk_bf16(v1[0], v1[1]); w.w = cvt_pk_bf16(v1[2], v1[3]);
                            *(u32x4*)(P + (size_t)row * PW + (pn < 8 ? gcol : gcol - 1024)) = w; }
                        else if (gcol < INC) { float* d = DT + (size_t)row * 16 + (gcol - 5632); *(f32x4*)d = v0; *(f32x4*)(d + 4) = v1; }
                    }
                }
            }
    }
};
struct EpiResid {
    static constexpr bool PREFETCH_SSQ = false;
    bf16_t* XB; float* ssqp;
    __device__ __forceinline__ void operator()(f32x4 (&acc)[2][2][4][2], const pg8::Unit& u, int wr, int wc, int fr, int fq, LAS unsigned char* lds) const {
        const int row0 = u.pm * 256 + wr * 64 + fr, col0 = u.pn * 256 + wc * 32 + 8 * fq;
#pragma unroll
        for (int ai = 0; ai < 2; ++ai) {
            u32x4 bs[4][2];
#pragma unroll
            for (int m = 0; m < 4; ++m)
#pragma unroll
                for (int bj = 0; bj < 2; ++bj) bs[m][bj] = *(const u32x4*)(XB + (size_t)(row0 + ai * 128 + m * 16) * DM + col0 + bj * 128);
            asm volatile("" ::: "memory");
#pragma unroll
            for (int m = 0; m < 4; ++m) {
                const int row = row0 + ai * 128 + m * 16; float ss = 0.f;
#pragma unroll
                for (int bj = 0; bj < 2; ++bj) {
                    const size_t off = (size_t)row * DM + col0 + bj * 128;
                    float b[8]; unpack8(bs[m][bj], b);
                    const f32x4 v0 = acc[ai][bj][m][0] + (f32x4){b[0], b[1], b[2], b[3]}, v1 = acc[ai][bj][m][1] + (f32x4){b[4], b[5], b[6], b[7]};
                    u32x4 w; w.x = cvt_pk_bf16(v0[0], v0[1]); w.y = cvt_pk_bf16(v0[2], v0[3]); w.z = cvt_pk_bf16(v1[0], v1[1]); w.w = cvt_pk_bf16(v1[2], v1[3]);
                    *(u32x4*)(XB + off) = w;
                    ss += ((v0[0] * v0[0] + v0[1] * v0[1]) + (v0[2] * v0[2] + v0[3] * v0[3])) + ((v1[0] * v1[0] + v1[1] * v1[1]) + (v1[2] * v1[2] + v1[3] * v1[3]));
                }
                ss += __shfl_xor(ss, 16); ss += __shfl_xor(ss, 32);
                if (fq == 0) ssqp[(size_t)row * 16 + u.pn * 4 + wc] = ss;
            }
        }
    }
};
struct EpiFinal {
    static constexpr bool PREFETCH_SSQ = false;
    const bf16_t* XB; float* out; float* ssqp; unsigned* cnt; const float* fw;
    __device__ __forceinline__ void operator()(f32x4 (&acc)[2][2][4][2], const pg8::Unit& u, int wr, int wc, int fr, int fq, LAS unsigned char* lds) const {
        const int row0 = u.pm * 256 + wr * 64 + fr, col0 = u.pn * 256 + wc * 32 + 8 * fq;
#pragma unroll
        for (int ai = 0; ai < 2; ++ai) {
            u32x4 bs[4][2];
#pragma unroll
            for (int m = 0; m < 4; ++m)
#pragma unroll
                for (int bj = 0; bj < 2; ++bj) bs[m][bj] = *(const u32x4*)(XB + (size_t)(row0 + ai * 128 + m * 16) * DM + col0 + bj * 128);
            asm volatile("" ::: "memory");
#pragma unroll
            for (int m = 0; m < 4; ++m) {
                const int row = row0 + ai * 128 + m * 16; float ss = 0.f;
#pragma unroll
                for (int bj = 0; bj < 2; ++bj) {
                    float b[8]; unpack8(bs[m][bj], b);
                    const f32x4 v0 = acc[ai][bj][m][0] + (f32x4){b[0], b[1], b[2], b[3]}, v1 = acc[ai][bj][m][1] + (f32x4){b[4], b[5], b[6], b[7]};
                    acc[ai][bj][m][0] = v0; acc[ai][bj][m][1] = v1;
                    ss += ((v0[0] * v0[0] + v0[1] * v0[1]) + (v0[2] * v0[2] + v0[3] * v0[3])) + ((v1[0] * v1[0] + v1[1] * v1[1]) + (v1[2] * v1[2] + v1[3] * v1[3]));
                }
                ss += __shfl_xor(ss, 16); ss += __shfl_xor(ss, 32);
                if (fq == 0) __hip_atomic_store(ssqp + (size_t)row * 16 + u.pn * 4 + wc, ss, __ATOMIC_RELAXED, __HIP_MEMORY_SCOPE_AGENT);
            }
        }
        asm volatile("s_waitcnt vmcnt(0)" ::: "memory");
        unsigned* pc = cnt + 64 * u.pm;
        const int ln = lane_id();
        if (ln == 0) __hip_atomic_fetch_add(pc, 1u, __ATOMIC_RELAXED, __HIP_MEMORY_SCOPE_AGENT);
        if (wr == 0 && wc == 0) { unsigned sp = 0u;
          while ((unsigned)__builtin_amdgcn_readfirstlane((int)__hip_atomic_load(pc, __ATOMIC_RELAXED, __HIP_MEMORY_SCOPE_AGENT)) < 32u) { if (++sp > (1u << 20)) break; __builtin_amdgcn_s_sleep(2); } }
        __builtin_amdgcn_s_barrier();
        __builtin_amdgcn_fence(__ATOMIC_ACQUIRE, "agent");
        asm volatile("s_waitcnt vmcnt(0)" ::: "memory");
#pragma unroll
        for (int ai = 0; ai < 2; ++ai)
#pragma unroll
            for (int m = 0; m < 4; ++m) {
                const int row = row0 + ai * 128 + m * 16;
                const f32x4 p4 = *(const f32x4*)(ssqp + (size_t)row * 16 + 4 * fq);
                float tot = (p4.x + p4.y) + (p4.z + p4.w); tot += __shfl_xor(tot, 16); tot += __shfl_xor(tot, 32);
                const float rs = rsqrtf(tot * (1.f / 1024.f) + EPS);
#pragma unroll
                for (int bj = 0; bj < 2; ++bj) {
                    const size_t off = (size_t)row * DM + col0 + bj * 128;
                    const f32x4 w0 = *(const f32x4*)(fw + col0 + bj * 128), w1 = *(const f32x4*)(fw + col0 + bj * 128 + 4);
                    *(f32x4*)(out + off) = acc[ai][bj][m][0] * rs * w0; *(f32x4*)(out + off + 4) = acc[ai][bj][m][1] * rs * w1;
                }
            }
    }
};
struct EpiUp {
    static constexpr bool PREFETCH_SSQ = true;
    bf16_t* H; const float* ssqp;
    __device__ __forceinline__ void operator()(f32x4 (&acc)[2][2][4][2], const pg8::Unit& u, int wr, int wc, int fr, int fq, LAS unsigned char* lds) const {
        const int row0 = u.pm * 256 + wr * 64 + fr, col0 = u.pn * 256 + wc * 32 + 8 * fq;
#pragma unroll
        for (int ai = 0; ai < 2; ++ai)
#pragma unroll
            for (int m = 0; m < 4; ++m) {
                const int row = row0 + ai * 128 + m * 16; const float rs = row_rstd_lds(lds, ai * 128 + wr * 64 + m * 16 + fr);
#pragma unroll
                for (int bj = 0; bj < 2; ++bj) {
                    f32x4 v0 = acc[ai][bj][m][0] * rs, v1 = acc[ai][bj][m][1] * rs;
#pragma unroll
                    for (int e = 0; e < 4; ++e) { const float a = fmaxf(v0[e], 0.f), b = fmaxf(v1[e], 0.f); v0[e] = a * a; v1[e] = b * b; }
                    u32x4 w; w.x = cvt_pk_bf16(v0[0], v0[1]); w.y = cvt_pk_bf16(v0[2], v0[3]); w.z = cvt_pk_bf16(v1[0], v1[1]); w.w = cvt_pk_bf16(v1[2], v1[3]);
                    *(u32x4*)(H + (size_t)row * FF + col0 + bj * 128) = w;
                }
            }
    }
};


#define XB_TMO      128
#define XB_XCNT(j)  (256  + 64 * (j))
#define XB_XSUB(j)  (1280 + 64 * (j))
#define XB_XGEN(j)  (2304 + 64 * (j))
#define XB_TOP      3328
#define XB_TOPGEN   3392
#define XCD_BAR_WORDS 3456
#define XB_SPIN_CAP (1u << 18)
__device__ __forceinline__ unsigned xb_ld(unsigned* p)              { return __hip_atomic_load(p, __ATOMIC_RELAXED, __HIP_MEMORY_SCOPE_AGENT); }
__device__ __forceinline__ unsigned xb_add(unsigned* p, unsigned v) { return __hip_atomic_fetch_add(p, v, __ATOMIC_RELAXED, __HIP_MEMORY_SCOPE_AGENT); }
__device__ __forceinline__ unsigned xb_xcc_id() { return (unsigned)__builtin_amdgcn_s_getreg((3 << 11) | 20) & 0xFu; }
#define XB_SPIN(cond, bar) do { unsigned _sp = 0; while (cond) { __builtin_amdgcn_s_sleep(1); \
    if ((++_sp & 255u) == 0u) { if (xb_ld(&(bar)[XB_TMO])) break; if (_sp > XB_SPIN_CAP) { atomicAdd(&(bar)[XB_TMO], 1u); break; } } } } while (0)
struct XcdBarrier { unsigned* bar; unsigned x; volatile LAS unsigned* st; };
__device__ __forceinline__ XcdBarrier xcd_barrier_post(unsigned* bar, volatile LAS unsigned* st) {
    XcdBarrier b; b.bar = bar; b.x = xb_xcc_id(); b.st = st;
    if (threadIdx.x == 0) (void)xb_add(&bar[XB_XCNT(b.x)], 1u);
    return b;
}
__device__ __forceinline__ void xcd_barrier_complete(unsigned* bar, unsigned x, unsigned& nloc, unsigned& nx) {
    const unsigned G = gridDim.x * gridDim.y * gridDim.z;
    unsigned sum, cnt, mine, sp = 0u;
    for (;;) {
        sum = 0u; cnt = 0u; mine = 0u;
#pragma unroll
        for (unsigned j = 0; j < 16; ++j) { const unsigned c = xb_ld(&bar[XB_XCNT(j)]); sum += c; cnt += (c > 0u) ? 1u : 0u; mine = (j == x) ? c : mine; }
        if (sum == G) break;
        __builtin_amdgcn_s_sleep(1);
        if ((++sp & 255u) == 0u) { if (xb_ld(&bar[XB_TMO])) break; if (sp > XB_SPIN_CAP) { atomicAdd(&bar[XB_TMO], 1u); break; } }
    }
    nloc = mine > 0u ? mine : 1u; nx = cnt > 0u ? cnt : 1u;
}
__device__ __forceinline__ void xcd_barrier(const XcdBarrier& b) {
    asm volatile("s_waitcnt vmcnt(0)" ::: "memory");
    __syncthreads();
    if (threadIdx.x == 0) {
        unsigned* bar = b.bar;
        __builtin_amdgcn_s_waitcnt(0);
        unsigned nloc = b.st[0], nx = b.st[1];
        if (nloc == 0u) { xcd_barrier_complete(bar, b.x, nloc, nx); b.st[0] = nloc; b.st[1] = nx; }
        const unsigned old = xb_add(&bar[XB_XSUB(b.x)], 1u);
        const unsigned gen = old / nloc;
        if (old + 1u == (gen + 1u) * nloc) {
            __builtin_amdgcn_fence(__ATOMIC_RELEASE, "agent");
            asm volatile("s_waitcnt vmcnt(0)" ::: "memory");
            const unsigned og = xb_add(&bar[XB_TOP], 1u);
            const unsigned tg = og / nx;
            if (og + 1u == (tg + 1u) * nx) xb_add(&bar[XB_TOPGEN], 1u);
            else XB_SPIN(xb_ld(&bar[XB_TOPGEN]) == tg, bar);
            __builtin_amdgcn_fence(__ATOMIC_ACQUIRE, "agent");
            xb_add(&bar[XB_XGEN(b.x)], 1u);
            asm volatile("s_waitcnt vmcnt(0)" ::: "memory");
        } else {
            XB_SPIN(xb_ld(&bar[XB_XGEN(b.x)]) == gen, bar);
            __builtin_amdgcn_fence(__ATOMIC_ACQUIRE, "agent");
            asm volatile("s_waitcnt vmcnt(0)" ::: "memory");
        }
    }
    __syncthreads();
}

struct Args { const float* in[15]; float* out; unsigned char* ws; int ph_lo, ph_hi; };

__device__ __forceinline__ float wave_sum(float v) {
#pragma unroll
    for (int o = 1; o < 64; o <<= 1) v += __shfl_xor(v, o);
    return v;
}

template <bool PERMROW>
__device__ __forceinline__ void transpose_item(const float* W, int K, int N, int nblk, bf16_t* WT, const float* scale, LAS float* scr, int item, int lane) {
    const int kb = item / nblk, nb = item % nblk, k0 = 64 * kb, n0 = 32 * nb;
    const int n = n0 + (lane & 31);
    const float* wp = W + (size_t)(k0 + (lane >> 5)) * N + n;
    float v[32];
    if (n < N) {
#pragma unroll
        for (int i = 0; i < 32; ++i) v[i] = wp[(size_t)(2 * i) * N];
    } else {
#pragma unroll
        for (int i = 0; i < 32; ++i) v[i] = 0.f;
    }
    const int c = lane & 7;
    f32x4 s0 = (f32x4){1.f, 1.f, 1.f, 1.f}, s1 = s0;
    if (scale) { s0 = *(const f32x4*)(scale + k0 + 8 * c); s1 = *(const f32x4*)(scale + k0 + 8 * c + 4); }
    asm volatile("" ::: "memory");
#pragma unroll
    for (int i = 0; i < 32; ++i) scr[(2 * i + (lane >> 5)) * 33 + (lane & 31)] = v[i];
    asm volatile("s_waitcnt lgkmcnt(0)" ::: "memory");
#pragma unroll
    for (int j = 0; j < 4; ++j) { const int nn = (lane >> 3) + 8 * j; const LAS float* sp = scr + (8 * c) * 33 + nn;
        u32x4 o; o.x = cvt_pk_bf16(sp[0 * 33] * s0.x, sp[1 * 33] * s0.y); o.y = cvt_pk_bf16(sp[2 * 33] * s0.z, sp[3 * 33] * s0.w); o.z = cvt_pk_bf16(sp[4 * 33] * s1.x, sp[5 * 33] * s1.y); o.w = cvt_pk_bf16(sp[6 * 33] * s1.z, sp[7 * 33] * s1.w);
        int row = n0 + nn;
        if (PERMROW) {
            if (row >= 1024 && row < 3072) { const int hsel = (row >= 2048) ? 1 : 0, ch = row - 1024 - 1024 * hsel; row = 2048 + 256 * (ch >> 7) + 128 * hsel + (ch & 127); }
            else if (row >= 3072 && row < 4096) row -= 2048; }
        *(u32x4*)(WT + (size_t)row * K + k0 + 8 * c) = o; }
    asm volatile("s_waitcnt lgkmcnt(0)" ::: "memory");
}
__device__ __forceinline__ void convert_layer(const Args& a, int layer, unsigned char* wb, LAS float* scr, int wi, int nw, int lane, int it_lo = 0, int it_hi = 1 << 30) {
    constexpr int I_IN = 16 * 177, I_OUT = 32 * 32, I_UP = 16 * 128, I_DN = 64 * 32;
    const float* w_in = a.in[2] + (size_t)layer * DM * INC; const float* w_out = a.in[10] + (size_t)layer * MIXW * DM;
    const float* w_up = a.in[12] + (size_t)layer * DM * FF; const float* w_dn = a.in[13] + (size_t)layer * FF * DM;
    const int it_end = (it_hi < I_IN + I_OUT + I_UP + I_DN) ? it_hi : I_IN + I_OUT + I_UP + I_DN;
    for (int it = it_lo + wi; it < it_end; it += nw) {
        int r = it;
        if (r < I_IN) { transpose_item<true>(w_in, DM, INC, 177, (bf16_t*)(wb + WB_IN), a.in[1] + layer * DM, scr, r, lane); continue; } r -= I_IN;
        if (r < I_OUT) { transpose_item<false>(w_out, MIXW, DM, 32, (bf16_t*)(wb + WB_OUT), nullptr, scr, r, lane); continue; } r -= I_OUT;
        if (r < I_UP) { transpose_item<false>(w_up, DM, FF, 128, (bf16_t*)(wb + WB_UP), a.in[11] + layer * DM, scr, r, lane); continue; } r -= I_UP;
        transpose_item<false>(w_dn, FF, DM, 32, (bf16_t*)(wb + WB_DN), nullptr, scr, r, lane);
    }
}

constexpr int CONV_SPLIT = 4608;
constexpr int L_XS = 0;
constexpr int L_B = 73728;
constexpr int L_C = 92160;
constexpr int L_M = 109568;
constexpr int L_DT = 128000;
constexpr int L_AC = 130048;
constexpr int L_RED = 132096;

__device__ __forceinline__ int tr_off(int row, int tok) { return row * 72 + ((((tok >> 3) ^ (row >> 3)) & 7) << 3) + (tok & 7); }
template <bool TRANS>
__device__ __forceinline__ void conv4_chunk(const bf16_t* src, int tb0, const float* cw, const float* cb, LAS bf16_t* dst, int row0, int tok0) {
    u32x4 raw[19];
#pragma unroll
    for (int j = 0; j < 11; ++j) raw[j] = *(const u32x4*)(src + (long)(j - 3) * PW);
    float w[4][8], bias[8];
#pragma unroll
    for (int k = 0; k < 4; ++k) { const f32x4 a = *(const f32x4*)(cw + k * 1536), b = *(const f32x4*)(cw + k * 1536 + 4);
        w[k][0] = a.x; w[k][1] = a.y; w[k][2] = a.z; w[k][3] = a.w; w[k][4] = b.x; w[k][5] = b.y; w[k][6] = b.z; w[k][7] = b.w; }
    { const f32x4 a = *(const f32x4*)cb, b = *(const f32x4*)(cb + 4); bias[0] = a.x; bias[1] = a.y; bias[2] = a.z; bias[3] = a.w; bias[4] = b.x; bias[5] = b.y; bias[6] = b.z; bias[7] = b.w; }
    asm volatile("" ::: "memory");
    if (tb0 == 0) { raw[0] = (u32x4){0u, 0u, 0u, 0u}; raw[1] = raw[0]; raw[2] = raw[0]; }
    float r0[8], r1[8], r2[8], prev[8];
    unsigned pk[8][2];
    unpack8(raw[0], r0); unpack8(raw[1], r1); unpack8(raw[2], r2);
#pragma unroll
    for (int j = 0; j < 16; ++j) {
        if (j == 0) {
            asm volatile("" ::: "memory");
#pragma unroll
            for (int jj = 11; jj < 19; ++jj) raw[jj] = *(const u32x4*)(src + (long)(jj - 3) * PW);
            asm volatile("" ::: "memory");
        }
        float cur[8], o[8]; unpack8(raw[j + 3], cur);
#pragma unroll
        for (int e = 0; e < 8; ++e) { const float v = bias[e] + w[0][e] * r0[e] + w[1][e] * r1[e] + w[2][e] * r2[e] + w[3][e] * cur[e]; o[e] = silu_f(v); }
        if (TRANS) {
            if (j & 1) {
#pragma unroll
                for (int e = 0; e < 8; ++e) pk[e][(j & 3) >> 1] = cvt_pk_bf16(prev[e], o[e]);
            } else {
#pragma unroll
                for (int e = 0; e < 8; ++e) prev[e] = o[e];
            }
            if ((j & 3) == 3) {
                LAS bf16_t* bg = dst + row0 * 72 + (((((tok0 + j) >> 3) ^ (row0 >> 3)) & 7) << 3) + ((j - 3) & 7);
#pragma unroll
                for (int e = 0; e < 8; ++e) { u32x2 v; v.x = pk[e][0]; v.y = pk[e][1]; *(LAS u32x2*)(bg + e * 72) = v; }
            }
        } else { *(LAS u32x4*)(dst + (tok0 + j) * 136 + row0) = pack8(o); }
#pragma unroll
        for (int e = 0; e < 8; ++e) { r0[e] = r1[e]; r1[e] = r2[e]; r2[e] = cur[e]; }
    }
}

template <bool S1>
__device__ __forceinline__ void ssd_stage(const Args& a, int layer, LAS unsigned char* L, const bf16_t* PROJ, const float* DTB, int b, int c, int g, int tid) {
    const int rowbase = b * SEQ + c * 64;
    if (tid < 384) {
        const int wv = tid >> 6, ln = tid & 63;
        const float* cw = a.in[4] + (size_t)layer * 4 * 1536; const float* cb = a.in[5] + (size_t)layer * 1536;
        if (wv < 4) { const int q = ln, tg = wv, xc = 512 * g + 8 * q, tb0 = c * 64 + 16 * tg;
            const bf16_t* srow = PROJ + (size_t)(rowbase + 16 * tg) * PW + C_XBC;
            conv4_chunk<true>(srow + xc, tb0, cw + xc, cb + xc, (LAS bf16_t*)(L + L_XS), 8 * q, 16 * tg); }
        else if (wv == 4) { const int n = 8 * (ln & 15), tg = ln >> 4, xc = 1024 + 128 * g + n, tb0 = c * 64 + 16 * tg;
            const bf16_t* srow = PROJ + (size_t)(rowbase + 16 * tg) * PW + C_XBC;
            if (S1) conv4_chunk<true>(srow + xc, tb0, cw + xc, cb + xc, (LAS bf16_t*)(L + L_B), n, 16 * tg);
            else conv4_chunk<false>(srow + xc, tb0, cw + xc, cb + xc, (LAS bf16_t*)(L + L_B), n, 16 * tg); }
        else if (!S1) { const int n = 8 * (ln & 15), tg = ln >> 4, xc = 1280 + 128 * g + n, tb0 = c * 64 + 16 * tg;
            const bf16_t* srow = PROJ + (size_t)(rowbase + 16 * tg) * PW + C_XBC;
            conv4_chunk<false>(srow + xc, tb0, cw + xc, cb + xc, (LAS bf16_t*)(L + L_C), n, 16 * tg); }
    } else {
        const int t2 = tid - 384, tl = t2 & 63, hh = t2 >> 6;
        const f32x4 raw = *(const f32x4*)(DTB + (size_t)(rowbase + tl) * 16 + 8 * g + 4 * hh);
        LAS float* dtL = (LAS float*)(L + L_DT); LAS float* acL = (LAS float*)(L + L_AC);
#pragma unroll
        for (int i = 0; i < 4; ++i) {
            const int h = 8 * g + 4 * hh + i;
            const float v = raw[i] + a.in[6][layer * 16 + h];
            const float dt = fmaxf(v, 0.f) + log1pf(expf(-fabsf(v)));
            float cum = dt * (-expf(a.in[7][layer * 16 + h]));
#pragma unroll
            for (int off = 1; off < 64; off <<= 1) { const float t = __shfl_up(cum, off); if (tl >= off) cum += t; }
            dtL[(4 * hh + i) * 64 + tl] = dt; acL[(4 * hh + i) * 64 + tl] = cum;
        }
    }
}

__device__ __forceinline__ void conv_mixer(const Args& a, int layer, bf16_t* PROJ, int b, int c, int g, int tid) {
    const int q = tid & 63, tg = tid >> 6, ch = 512 * g + 8 * q;
    const int tb0 = c * 64 + 8 * tg;
    bf16_t* p = PROJ + (size_t)(b * SEQ + tb0) * PW + ch;
    u32x4 rp[10], rb[8];
#pragma unroll
    for (int j = 0; j < 10; ++j) rp[j] = *(const u32x4*)(p + (long)(j - 2) * PW + 2048);
#pragma unroll
    for (int j = 0; j < 8; ++j) rb[j] = *(const u32x4*)(p + (long)j * PW);
    const float* sw = a.in[3] + (size_t)layer * 3 * 1024 + ch;
    float w[3][8];
#pragma unroll
    for (int k = 0; k < 3; ++k) { const f32x4 x = *(const f32x4*)(sw + k * 1024), y = *(const f32x4*)(sw + k * 1024 + 4);
        w[k][0] = x.x; w[k][1] = x.y; w[k][2] = x.z; w[k][3] = x.w; w[k][4] = y.x; w[k][5] = y.y; w[k][6] = y.z; w[k][7] = y.w; }
    asm volatile("" ::: "memory");
    if (tb0 == 0) { rp[0] = (u32x4){0u, 0u, 0u, 0u}; rp[1] = rp[0]; }
    float p0[8], p1[8];
    unpack8(rp[0], p0); unpack8(rp[1], p1);
#pragma unroll
    for (int j = 0; j < 8; ++j) {
        float cur[8], ub[8], o[8];
        unpack8(rp[j + 2], cur); unpack8(rb[j], ub);
#pragma unroll
        for (int e = 0; e < 8; ++e) { o[e] = ub[e] * (w[0][e] * p0[e] + w[1][e] * p1[e] + w[2][e] * cur[e]); p0[e] = p1[e]; p1[e] = cur[e]; }
        *(u32x4*)(p + (long)j * PW) = pack8(o);
    }
}

__device__ __forceinline__ void phase_s1(const Args& a, int layer, LAS unsigned char* L, const int wave) {
    int lane_ = lane_id(); asm volatile("" : "+v"(lane_)); const int lane = lane_, tid0 = wave * 64 + lane;
    bf16_t* PROJ = (bf16_t*)(a.ws + WS_PROJ); const float* DTB = (const float*)(a.ws + WS_DT);
    bf16_t* ST = (bf16_t*)(a.ws + WS_ST); float* CD = (float*)(a.ws + WS_CD);
    const int fr = lane & 15, fq = lane >> 4;
    for (int u = blockIdx.x; u < NB * NCH * 2; u += gridDim.x) {
        const int b = u >> 8, c = (u & 255) >> 1, g = u & 1;
        int tid = tid0; asm volatile("" : "+v"(tid));
        conv_mixer(a, layer, PROJ, b, c, g, tid);
        ssd_stage<true>(a, layer, L, PROJ, DTB, b, c, g, tid);
        __syncthreads();
        const int h = 8 * g + wave;
        const LAS float* dtw = (const LAS float*)(L + L_DT) + wave * 64; const LAS float* acw = (const LAS float*)(L + L_AC) + wave * 64;
        const float aend = acw[63];
        bf16x8 xw[4][2];
#pragma unroll
        for (int ks = 0; ks < 2; ++ks) {
            float wv[8];
#pragma unroll
            for (int e = 0; e < 8; ++e) { const int l = 32 * ks + 8 * fq + e; wv[e] = dtw[l] * __expf(aend - acw[l]); }
#pragma unroll
            for (int pt = 0; pt < 4; ++pt) {
                const u32x4 raw = *(const LAS u32x4*)((const LAS bf16_t*)(L + L_XS) + tr_off(64 * wave + 16 * pt + fr, 32 * ks + 8 * fq));
                float x[8]; unpack8(raw, x);
#pragma unroll
                for (int e = 0; e < 8; ++e) x[e] *= wv[e];
                const u32x4 pk = pack8(x); xw[pt][ks] = __builtin_bit_cast(bf16x8, pk);
            }
        }
        bf16_t* stp = ST + (size_t)((b * NCH + c) * 16 + h) * 8192;
#pragma unroll
        for (int half = 0; half < 2; ++half) {
            f32x4 acc[4][4];
#pragma unroll
            for (int i = 0; i < 4; ++i)
#pragma unroll
                for (int j = 0; j < 4; ++j) acc[i][j] = (f32x4){0.f, 0.f, 0.f, 0.f};
#pragma unroll
            for (int nt = 0; nt < 4; ++nt)
#pragma unroll
                for (int ks = 0; ks < 2; ++ks) {
                    const bf16x8 bf = *(const LAS bf16x8*)((const LAS bf16_t*)(L + L_B) + tr_off(64 * half + 32 * (nt >> 1) + 8 * (fr >> 2) + 4 * (nt & 1) + (fr & 3), 32 * ks + 8 * fq));
#pragma unroll
                    for (int pt = 0; pt < 4; ++pt) acc[nt][pt] = __builtin_amdgcn_mfma_f32_16x16x32_f16(bf, xw[pt][ks], acc[nt][pt], 0, 0, 0);
                }
#pragma unroll
            for (int k2 = 0; k2 < 2; ++k2)
#pragma unroll
                for (int pt = 0; pt < 4; ++pt) { u32x4 w; w.x = cvt_pk_bf16(acc[2 * k2][pt][0], acc[2 * k2][pt][1]); w.y = cvt_pk_bf16(acc[2 * k2][pt][2], acc[2 * k2][pt][3]);
                    w.z = cvt_pk_bf16(acc[2 * k2 + 1][pt][0], acc[2 * k2 + 1][pt][1]); w.w = cvt_pk_bf16(acc[2 * k2 + 1][pt][2], acc[2 * k2 + 1][pt][3]);
                    *(u32x4*)(stp + (16 * pt + fr) * 128 + 64 * half + 32 * k2 + 8 * fq) = w; }
        }
        if (lane == 0) CD[(b * NCH + c) * 16 + h] = __expf(aend);
        __syncthreads();
    }
}

__device__ __forceinline__ void phase_s2(const Args& a, int layer, LAS unsigned char* L, const int wave) {
    int lane_ = lane_id(); asm volatile("" : "+v"(lane_)); const int lane = lane_, tid = wave * 64 + lane;
    if (wave < 4) {
        bf16_t* ST = (bf16_t*)(a.ws + WS_ST); const float* CD = (const float*)(a.ws + WS_CD);
        for (int wi = wave * gridDim.x + blockIdx.x; wi < 1024; wi += 4 * gridDim.x) {
            const int j = wi * 64 + lane, b = j >> 15, within = j & 32767, h = within >> 11;
            bf16_t* p = ST + (size_t)b * NCH * 131072 + (size_t)within * 4;
            const float* cd = CD + b * NCH * 16 + h;
            float H0 = 0.f, H1 = 0.f, H2 = 0.f, H3 = 0.f;
            for (int c0 = 0; c0 < NCH; c0 += 16) {
                u32x2 sv[16]; float d[16];
#pragma unroll
                for (int i = 0; i < 16; ++i) { sv[i] = *(const u32x2*)(p + (size_t)(c0 + i) * 131072); d[i] = cd[(c0 + i) * 16]; }
                asm volatile("" ::: "memory");
#pragma unroll
                for (int i = 0; i < 16; ++i) {
                    u32x2 o; o.x = cvt_pk_bf16(H0, H1); o.y = cvt_pk_bf16(H2, H3);
                    *(u32x2*)(p + (size_t)(c0 + i) * 131072) = o;
                    H0 = H0 * d[i] + bf_lo(sv[i].x); H1 = H1 * d[i] + bf_hi(sv[i].x); H2 = H2 * d[i] + bf_lo(sv[i].y); H3 = H3 * d[i] + bf_hi(sv[i].y);
                }
            }
        }
    } else if (layer + 1 < DEPTH) {
        convert_layer(a, layer + 1, a.ws + WS_WB + (size_t)((layer + 1) & 1) * WB_BYTES, (LAS float*)(L + wave * 16384), (wave - 4) * gridDim.x + blockIdx.x, 4 * gridDim.x, lane, (gridDim.x == 256) ? CONV_SPLIT : 0);
    }
}

__device__ __forceinline__ void phase_s3(const Args& a, int layer, LAS unsigned char* L, const int wave) {
    int lane_ = lane_id(); asm volatile("" : "+v"(lane_)); const int lane = lane_, tid0 = wave * 64 + lane;
    bf16_t* PROJ = (bf16_t*)(a.ws + WS_PROJ); const float* DTB = (const float*)(a.ws + WS_DT);
    const bf16_t* ST = (const bf16_t*)(a.ws + WS_ST);
    for (int u = blockIdx.x; u < NB * NCH * 2; u += gridDim.x) {
        const int b = u >> 8, c = (u & 255) >> 1, g = u & 1;
        int tid = tid0; asm volatile("" : "+v"(tid));
        const int h = 8 * g + wave, rowbase = b * SEQ + c * 64;
        ssd_stage<false>(a, layer, L, PROJ, DTB, b, c, g, tid);
        int ln2 = lane; asm volatile("" : "+v"(ln2));
        const int fr = ln2 & 15, fq = ln2 >> 4, frl = fr, fql = fq;
        const bf16_t* prevp = ST + (size_t)((b * NCH + c) * 16 + h) * 8192 + (8 * (frl >> 2) + (frl & 3)) * 128 + 8 * fql;
        bf16x8 pf[4][4];
#pragma unroll
        for (int ks = 0; ks < 4; ++ks)
#pragma unroll
            for (int pt = 0; pt < 4; ++pt) pf[ks][pt] = *(const bf16x8*)(prevp + (32 * (pt >> 1) + 4 * (pt & 1)) * 128 + 32 * ks);
        asm volatile("" ::: "memory");
        __syncthreads();
        const LAS float* dtw = (const LAS float*)(L + L_DT) + wave * 64; const LAS float* acw = (const LAS float*)(L + L_AC) + wave * 64;
        const LAS bf16_t* xsT = (const LAS bf16_t*)(L + L_XS);
        const LAS bf16_t* Bl = (const LAS bf16_t*)(L + L_B); const LAS bf16_t* Cl = (const LAS bf16_t*)(L + L_C);
        LAS bf16_t* Mw = (LAS bf16_t*)(L + L_M) + wave * 1152;
        float al[4];
#pragma unroll
        for (int lt = 0; lt < 4; ++lt) al[lt] = acw[16 * lt + fr];
        f32x4 acc[4][4];
#pragma unroll
        for (int i = 0; i < 4; ++i)
#pragma unroll
            for (int j = 0; j < 4; ++j) acc[i][j] = (f32x4){0.f, 0.f, 0.f, 0.f};
        u32x4 zr[4][2];
#pragma unroll
        for (int lt = 0; lt < 4; ++lt)
#pragma unroll
            for (int k2 = 0; k2 < 2; ++k2) zr[lt][k2] = *(const u32x4*)(PROJ + (size_t)(rowbase + 16 * lt + fr) * PW + 1024 + 64 * h + 32 * k2 + 8 * fq);
        asm volatile("" ::: "memory");
#pragma unroll
        for (int lt = 0; lt < 4; ++lt) {
            bf16x8 cf[4];
#pragma unroll
            for (int ks = 0; ks < 4; ++ks) cf[ks] = *(const LAS bf16x8*)(Cl + (16 * lt + fr) * 136 + 32 * ks + 8 * fq);
#pragma unroll
            for (int st = 0; st < 4; ++st) {
                f32x4 m = (f32x4){0.f, 0.f, 0.f, 0.f};
                if (st <= lt) {
                    f32x4 sc = (f32x4){0.f, 0.f, 0.f, 0.f};
#pragma unroll
                    for (int ks = 0; ks < 4; ++ks) { const bf16x8 bfr = *(const LAS bf16x8*)(Bl + (16 * st + fr) * 136 + 32 * ks + 8 * fq); sc = __builtin_amdgcn_mfma_f32_16x16x32_f16(bfr, cf[ks], sc, 0, 0, 0); }
#pragma unroll
                    for (int r = 0; r < 4; ++r) { const int s = 16 * st + 4 * fq + r, l = 16 * lt + fr; const float v = sc[r] * __expf(al[lt] - acw[s]) * dtw[s]; m[r] = (s <= l) ? v : 0.f; }
                }
                u32x2 w; w.x = cvt_pk_bf16(m[0], m[1]); w.y = cvt_pk_bf16(m[2], m[3]);
                *(LAS u32x2*)(Mw + fr * 72 + 16 * st + 4 * fq) = w;
            }
            asm volatile("s_waitcnt lgkmcnt(0)" ::: "memory");
#pragma unroll
            for (int ks = 0; ks < 2; ++ks) { const bf16x8 mf = *(const LAS bf16x8*)(Mw + fr * 72 + 32 * ks + 8 * fq);
#pragma unroll
                for (int pt = 0; pt < 4; ++pt) { const bf16x8 xf = *(const LAS bf16x8*)(xsT + tr_off(64 * wave + 32 * (pt >> 1) + 8 * (fr >> 2) + 4 * (pt & 1) + (fr & 3), 32 * ks + 8 * fq)); acc[lt][pt] = __builtin_amdgcn_mfma_f32_16x16x32_f16(xf, mf, acc[lt][pt], 0, 0, 0); } }
            asm volatile("s_waitcnt lgkmcnt(0)" ::: "memory");
        }
#pragma unroll
        for (int lt = 0; lt < 4; ++lt) {
            f32x4 a2[4];
#pragma unroll
            for (int pt = 0; pt < 4; ++pt) a2[pt] = (f32x4){0.f, 0.f, 0.f, 0.f};
#pragma unroll
            for (int ks = 0; ks < 4; ++ks) { const bf16x8 cf = *(const LAS bf16x8*)(Cl + (16 * lt + fr) * 136 + 32 * ks + 8 * fq);
#pragma unroll
                for (int pt = 0; pt < 4; ++pt) a2[pt] = __builtin_amdgcn_mfma_f32_16x16x32_f16(pf[ks][pt], cf, a2[pt], 0, 0, 0); }
            const float e = __expf(al[lt]);
#pragma unroll
            for (int pt = 0; pt < 4; ++pt) acc[lt][pt] = acc[lt][pt] + a2[pt] * e;
        }
        const float dsk = a.in[8][layer * 16 + h];
        LAS float* red = (LAS float*)(L + L_RED);
#pragma unroll
        for (int lt = 0; lt < 4; ++lt) {
            const int l = 16 * lt + fr; float ss = 0.f;
#pragma unroll
            for (int k2 = 0; k2 < 2; ++k2) {
                float zz[8]; unpack8(zr[lt][k2], zz);
#pragma unroll
                for (int o2 = 0; o2 < 2; ++o2)
#pragma unroll
                    for (int r = 0; r < 4; ++r) { const int pt = 2 * k2 + o2, p = 32 * k2 + 8 * fq + 4 * o2 + r;
                        const float xs = bf2f(xsT[tr_off(64 * wave + p, l)]); const float y = acc[lt][pt][r] + dsk * xs; const float gt = y * silu_f(zz[4 * o2 + r]); acc[lt][pt][r] = gt; ss += gt * gt; }
            }
            ss += __shfl_xor(ss, 16); ss += __shfl_xor(ss, 32);
            if (fq == 0) red[wave * 64 + l] = ss;
        }
        __syncthreads();
        const float* nw = a.in[9] + (size_t)layer * 1024 + 64 * h;
#pragma unroll
        for (int lt = 0; lt < 4; ++lt) {
            const int l = 16 * lt + fr; float tot = 0.f;
#pragma unroll
            for (int w8 = 0; w8 < 8; ++w8) tot += red[w8 * 64 + l];
            const float rs = rsqrtf(tot * (1.f / 512.f) + EPS);
#pragma unroll
            for (int k2 = 0; k2 < 2; ++k2) {
                const int pb = 32 * k2 + 8 * fq; const f32x4 n0 = *(const f32x4*)(nw + pb), n1 = *(const f32x4*)(nw + pb + 4);
                const f32x4 o0 = acc[lt][2 * k2] * rs * n0, o1 = acc[lt][2 * k2 + 1] * rs * n1;
                u32x4 w; w.x = cvt_pk_bf16(o0[0], o0[1]); w.y = cvt_pk_bf16(o0[2], o0[3]); w.z = cvt_pk_bf16(o1[0], o1[1]); w.w = cvt_pk_bf16(o1[2], o1[3]);
                *(u32x4*)(PROJ + (size_t)(rowbase + l) * PW + 1024 + 64 * h + pb) = w;
            }
        }
        __syncthreads();
    }
}

#define FUSE_FINAL (N_LAUNCH_MODE == 1)
#ifndef N_LAUNCH_MODE
#define N_LAUNCH_MODE 1
#endif
constexpr int NPHASE = 2 + 7 * DEPTH;

__global__ void __launch_bounds__(512, 2) trunk_fwd(Args args) {
    extern __shared__ __attribute__((aligned(16))) unsigned char lds_raw[];
    LAS unsigned char* L = (LAS unsigned char*)lds_raw;
    const int wave = __builtin_amdgcn_readfirstlane(threadIdx.x >> 6);
#define lane lane_id()
#define tid (wave * 64 + lane_id())
    const int G = gridDim.x;
    const int lo = args.ph_lo, hi = args.ph_hi;
    unsigned char* ws = args.ws;
    bf16_t* PROJ = (bf16_t*)(ws + WS_PROJ); bf16_t* HID = PROJ; bf16_t* XB = (bf16_t*)(ws + WS_XB);
    float* DTB = (float*)(ws + WS_DT); float* SSQ = (float*)(ws + WS_SSQ);
    float* X = args.out;
#define IN(k) (lo <= (k) && (k) < hi)
    volatile LAS unsigned* MISC = (volatile LAS unsigned*)(L + L_MISC);
    if (tid < 4) MISC[tid] = 0u;
    __syncthreads();
    XcdBarrier bar; bar.bar = (unsigned*)(ws + WS_BAR); bar.x = 0; bar.st = MISC;
    if (hi - lo > 1) bar = xcd_barrier_post((unsigned*)(ws + WS_BAR), MISC);
#define SEAM(k) do { if (IN(k) && IN((k) + 1)) xcd_barrier(bar); } while (0)
    if (IN(0)) {
        const int gw = blockIdx.x * 8 + wave, NGW = G * 8;
        convert_layer(args, 0, ws + WS_WB, (LAS float*)(L + wave * 16384), gw, NGW, lane);
        const float* x = args.in[0];
        for (int m = gw; m < M; m += 2 * NGW) {
            const int m2 = (m + NGW < M) ? m + NGW : m;
            const f32x4* xr = (const f32x4*)(x + (size_t)m * DM) + lane; const f32x4* xr2 = (const f32x4*)(x + (size_t)m2 * DM) + lane;
            float s = 0.f, s2 = 0.f; f32x4 v[4], v2[4];
#pragma unroll
            for (int j = 0; j < 4; ++j) { v[j] = xr[64 * j]; v2[j] = xr2[64 * j]; }
#pragma unroll
            for (int j = 0; j < 4; ++j) { s += (v[j].x * v[j].x + v[j].y * v[j].y) + (v[j].z * v[j].z + v[j].w * v[j].w); s2 += (v2[j].x * v2[j].x + v2[j].y * v2[j].y) + (v2[j].z * v2[j].z + v2[j].w * v2[j].w); }
            s = wave_sum(s); s2 = wave_sum(s2);
            u32x2* o = (u32x2*)(XB + (size_t)m * DM) + lane; u32x2* o2 = (u32x2*)(XB + (size_t)m2 * DM) + lane;
#pragma unroll
            for (int j = 0; j < 4; ++j) { u32x2 w; w.x = cvt_pk_bf16(v[j].x, v[j].y); w.y = cvt_pk_bf16(v[j].z, v[j].w); o[64 * j] = w;
                                          u32x2 w2; w2.x = cvt_pk_bf16(v2[j].x, v2[j].y); w2.y = cvt_pk_bf16(v2[j].z, v2[j].w); o2[64 * j] = w2; }
            if (lane < 16) { SSQ[(size_t)m * 16 + lane] = (lane == 0) ? s : 0.f; SSQ[(size_t)m2 * 16 + lane] = (lane == 0) ? s2 : 0.f; }
        }
    }
    SEAM(0);
    for (int layer = 0; layer < DEPTH; ++layer) {
        const int pb = 1 + 7 * layer;
        unsigned char* wb = ws + WS_WB + (size_t)(layer & 1) * WB_BYTES;
        if (IN(pb + 0)) {
            pg8::Gemm g{XB, (const bf16_t*)(wb + WB_IN), M, INP, DM, DM}; pg8::StaticOrder S; S.init(M, INP, G, (int)blockIdx.x);
            EpiInProj E{PROJ, DTB, SSQ};
            pg8::gemm_phase<EpiInProj, true>(L, g, S, E, wave);
            if (G == 256 && blockIdx.x >= 192 && layer + 1 < DEPTH)
                convert_layer(args, layer + 1, ws + WS_WB + (size_t)((layer + 1) & 1) * WB_BYTES, (LAS float*)(L + wave * 16384), wave * 64 + ((int)blockIdx.x - 192), 512, lane_id(), 0, CONV_SPLIT);
        }
        SEAM(pb + 0);
        if (IN(pb + 1)) phase_s1(args, layer, L, wave);
        SEAM(pb + 1);
        if (IN(pb + 2)) phase_s2(args, layer, L, wave);
        SEAM(pb + 2);
        if (IN(pb + 3)) phase_s3(args, layer, L, wave);
        SEAM(pb + 3);
        if (IN(pb + 4)) {
            pg8::Gemm g{PROJ, (const bf16_t*)(wb + WB_OUT), M, DM, MIXW, PW}; pg8::StaticOrder S; S.init(M, DM, G, (int)blockIdx.x);
            EpiResid E{XB, SSQ};
            pg8::gemm_phase<EpiResid, true>(L, g, S, E, wave);
        }
        SEAM(pb + 4);
        if (IN(pb + 5)) {
            pg8::Gemm g{XB, (const bf16_t*)(wb + WB_UP), M, FF, DM, DM}; pg8::StaticOrder S; S.init(M, FF, G, (int)blockIdx.x);
            EpiUp E{HID, SSQ};
            pg8::gemm_phase<EpiUp, true>(L, g, S, E, wave);
        }
        SEAM(pb + 5);
        if (IN(pb + 6)) {
            pg8::Gemm g{HID, (const bf16_t*)(wb + WB_DN), M, DM, FF, FF}; pg8::StaticOrder S; S.init(M, DM, G, (int)blockIdx.x);
            if (FUSE_FINAL && layer == DEPTH - 1 && G == 256) { EpiFinal E{XB, X, SSQ, (unsigned*)(ws + WS_BAR) + 4096, args.in[14]}; pg8::gemm_phase<EpiFinal, true>(L, g, S, E, wave); }
            else { EpiResid E{XB, SSQ}; pg8::gemm_phase<EpiResid, true>(L, g, S, E, wave); }
        }
        if (!(FUSE_FINAL && layer == DEPTH - 1 && G == 256)) SEAM(pb + 6);
    }
    if (IN(NPHASE - 1) && !(FUSE_FINAL && G == 256)) {
        const int gw = blockIdx.x * 8 + wave, NGW = G * 8;
        const f32x4* fw = (const f32x4*)args.in[14];
        for (int m = gw; m < M; m += 2 * NGW) {
            const int m2 = (m + NGW < M) ? m + NGW : m;
            const u32x4* xr = (const u32x4*)(XB + (size_t)m * DM); const u32x4* xr2 = (const u32x4*)(XB + (size_t)m2 * DM);
            u32x4 v[2], v2[2];
#pragma unroll
            for (int j = 0; j < 2; ++j) { v[j] = xr[lane + 64 * j]; v2[j] = xr2[lane + 64 * j]; }
            const float rs = row_rstd(SSQ, m), rs2 = row_rstd(SSQ, m2);
            f32x4* o = (f32x4*)(X + (size_t)m * DM); f32x4* o2 = (f32x4*)(X + (size_t)m2 * DM);
#pragma unroll
            for (int j = 0; j < 2; ++j) {
                const int e = 2 * (lane + 64 * j); const f32x4 w0 = fw[e], w1 = fw[e + 1];
                float a[8], b[8]; unpack8(v[j], a); unpack8(v2[j], b);
                o[e] = (f32x4){a[0], a[1], a[2], a[3]} * rs * w0; o[e + 1] = (f32x4){a[4], a[5], a[6], a[7]} * rs * w1;
                o2[e] = (f32x4){b[0], b[1], b[2], b[3]} * rs2 * w0; o2[e + 1] = (f32x4){b[4], b[5], b[6], b[7]} * rs2 * w1;
            }
        }
    }
#undef IN
#undef SEAM
#undef lane
#undef tid
}

extern "C" void kernel_launch(void* const* d_in, const int* in_sizes, int n_in, void* d_out, int out_size, void* d_ws, size_t ws_size, hipStream_t stream) {
    static int grid = 0;
    if (grid == 0) {
        if (n_in != 15 || out_size != M * DM || ws_size < WS_END) { fprintf(stderr, "kernel_launch: unexpected shapes (n_in %d out %d ws %zu)\n", n_in, out_size, ws_size); grid = -1; return; }
        int dev = 0, cus = 0, per_cu = 0;
        hipGetDevice(&dev); hipDeviceGetAttribute(&cus, hipDeviceAttributeMultiprocessorCount, dev);
        if (hipFuncSetAttribute((const void*)trunk_fwd, hipFuncAttributeMaxDynamicSharedMemorySize, LDS_BYTES) != hipSuccess) { fprintf(stderr, "kernel_launch: hipFuncSetAttribute failed\n"); grid = -1; return; }
        if (hipOccupancyMaxActiveBlocksPerMultiprocessor(&per_cu, (const void*)trunk_fwd, 512, LDS_BYTES) != hipSuccess || per_cu < 1) { fprintf(stderr, "kernel_launch: occupancy query says %d\n", per_cu); per_cu = 1; }
        (void)hipGetLastError();
        grid = cus;
    }
    if (grid < 0) return;
    if (hipMemsetAsync((char*)d_ws + WS_BAR, 0, BAR_BYTES, stream) != hipSuccess) { fprintf(stderr, "kernel_launch: memset failed\n"); return; }
    Args a{};
    for (int i = 0; i < 15; ++i) a.in[i] = (const float*)d_in[i];
    a.out = (float*)d_out; a.ws = (unsigned char*)d_ws;
#if N_LAUNCH_MODE == 1
    a.ph_lo = 0; a.ph_hi = NPHASE;
    void* kargs[] = {&a};
    hipError_t e = hipLaunchCooperativeKernel((const void*)trunk_fwd, dim3(grid), dim3(512), kargs, LDS_BYTES, stream);
    if (e != hipSuccess) fprintf(stderr, "cooperative launch failed: %s (grid %d)\n", hipGetErrorString(e), grid);
#else
    for (int p = 0; p < NPHASE; ++p) { a.ph_lo = p; a.ph_hi = p + 1; hipLaunchKernelGGL(trunk_fwd, dim3(grid), dim3(512), LDS_BYTES, stream, a); }
#endif
}
```
